# Optimizing an MI355X kernel written in HIP

```python
import jax, jax.numpy as jnp
from jax import lax
import numpy as np

D_MODEL = 1024
BATCH = 1
SEQ = 16384
DEPTH = 1
DEC_BATCH = 16
DEC_SEQ = 16
PAST_LEN = 1024

CHUNK = 64
Q_BLOCK = 128
FOX_HEADS = 8
FOX_HEAD_DIM = D_MODEL // FOX_HEADS
FOX_WIDTH = FOX_HEADS * FOX_HEAD_DIM
FOX_SCALE = FOX_HEAD_DIM ** -0.5
SSM_INNER = D_MODEL
SSM_HEAD_DIM = 64
SSM_HEADS = SSM_INNER // SSM_HEAD_DIM
SSM_GROUPS = 4
SSM_STATE = 128
CONV_WIDTH = 4
CONV_DIM = SSM_INNER + 2 * SSM_GROUPS * SSM_STATE
D_FF = 4 * D_MODEL
N_MOD = 6
EPS = 1e-6
IN_SIZES = (FOX_WIDTH, FOX_WIDTH, FOX_WIDTH, FOX_HEADS, SSM_INNER, CONV_DIM, SSM_HEADS, D_MODEL, D_MODEL)
IN_WIDTH = sum(IN_SIZES)

kernel_name = "fox_ssd_parallel_streaming_step"


def _rmsnorm(x, g):
    xf = x.astype(jnp.float32)
    y = xf * lax.rsqrt(jnp.mean(xf * xf, axis=-1, keepdims=True) + EPS)
    return (y * g.astype(jnp.float32)).astype(x.dtype)


def _causal_conv(u, prev, w, b):
    full = jnp.concatenate([prev.astype(u.dtype), u], axis=1)
    L = u.shape[1]
    y = b.astype(u.dtype)
    for i in range(CONV_WIDTH):
        y = y + full[:, i:i + L] * w[i].astype(u.dtype)
    return y, full[:, full.shape[1] - (CONV_WIDTH - 1):]


def _fox_block(q, k, v, fq, fk, qpos, kpos):
    s = jnp.einsum("bqhd,bkhd->bhqk", q, k).astype(jnp.float32) * FOX_SCALE
    s = s + jnp.swapaxes(fq, 1, 2)[..., :, None] - jnp.swapaxes(fk, 1, 2)[..., None, :]
    visible = kpos[None, :] <= qpos[:, None]
    s = jnp.where(visible, s, -jnp.inf)
    p = jax.nn.softmax(s, axis=-1).astype(v.dtype)
    return jnp.einsum("bhqk,bkhd->bqhd", p, v)


def _fox_attention(q, k_all, v_all, logf_all):
    b, L, h, d = q.shape
    T = k_all.shape[1]
    P = T - L
    F = jnp.cumsum(logf_all.astype(jnp.float32), axis=1)
    fq = F[:, P:]
    kpos = jnp.arange(T)
    qpos = P + jnp.arange(L)
    if L % Q_BLOCK != 0:
        return _fox_block(q, k_all, v_all, fq, F, qpos, kpos)
    nb = L // Q_BLOCK
    qb = jnp.swapaxes(q.reshape(b, nb, Q_BLOCK, h, d), 0, 1)
    fb = jnp.swapaxes(fq.reshape(b, nb, Q_BLOCK, h), 0, 1)
    pb = qpos.reshape(nb, Q_BLOCK)
    out = lax.map(lambda blk: _fox_block(blk[0], k_all, v_all, blk[1], F, blk[2], kpos), (qb, fb, pb))
    return jnp.swapaxes(out, 0, 1).reshape(b, L, h, d)


def _ssd(x, dt, A, Bm, Cm, d_skip, init_state):
    b, L, h, p = x.shape
    g, n = Bm.shape[2], Bm.shape[3]
    r = h // g
    Q = CHUNK if L % CHUNK == 0 else L
    c = L // Q
    xf = x.astype(jnp.float32)
    xd = (xf * dt[..., None]).reshape(b, c, Q, g, r, p)
    a = (dt * A).reshape(b, c, Q, g, r).transpose(0, 1, 3, 4, 2)
    a_cs = jnp.cumsum(a, axis=-1)
    Bc = Bm.astype(jnp.float32).reshape(b, c, Q, g, n)
    Cc = Cm.astype(jnp.float32).reshape(b, c, Q, g, n)
    causal = jnp.tril(jnp.ones((Q, Q), dtype=bool))
    lmat = jnp.exp(jnp.where(causal, a_cs[..., :, None] - a_cs[..., None, :], -jnp.inf))
    cb = jnp.einsum("bclgn,bcsgn->bcgls", Cc, Bc)
    y_diag = jnp.einsum("bcgls,bcgrls,bcsgrp->bclgrp", cb, lmat, xd)
    decay = jnp.exp(a_cs[..., -1:] - a_cs)
    chunk_states = jnp.einsum("bclgn,bcgrl,bclgrp->bcgrpn", Bc, decay, xd)
    chunk_decay = jnp.exp(a_cs[..., -1])

    def step(s, inp):
        cs, dk = inp
        return s * dk[..., None, None] + cs, s

    s0 = init_state.astype(jnp.float32).reshape(b, g, r, p, n)
    s_final, s_prev = lax.scan(step, s0, (jnp.moveaxis(chunk_states, 1, 0), jnp.moveaxis(chunk_decay, 1, 0)))
    s_prev = jnp.moveaxis(s_prev, 0, 1)
    y_off = jnp.einsum("bclgn,bcgrpn,bcgrl->bclgrp", Cc, s_prev, jnp.exp(a_cs))
    y = (y_diag + y_off).reshape(b, L, h, p) + xf * d_skip.astype(jnp.float32)[:, None]
    return y, s_final.reshape(b, h, p, n)


def _token_mixer(h, k_past, v_past, logf_past, conv_past, ssm_past,
                 w_in, b_f, conv_w, conv_b, dt_bias, a_log, d_skip, ssm_norm_g, w_out):
    b, L, _ = h.shape
    u = h @ w_in
    offs = np.cumsum(IN_SIZES)[:-1].tolist()
    q, k, v, f_raw, z, xbc, dt_raw, ga, gb = jnp.split(u, offs, axis=-1)
    q = q.reshape(b, L, FOX_HEADS, FOX_HEAD_DIM)
    k = k.reshape(b, L, FOX_HEADS, FOX_HEAD_DIM)
    v = v.reshape(b, L, FOX_HEADS, FOX_HEAD_DIM)
    logf = jax.nn.log_sigmoid(f_raw.astype(jnp.float32) + b_f.astype(jnp.float32))
    k_all = jnp.concatenate([k_past.astype(k.dtype), k], axis=1)
    v_all = jnp.concatenate([v_past.astype(v.dtype), v], axis=1)
    logf_all = jnp.concatenate([logf_past.astype(jnp.float32), logf], axis=1)
    y_att = _fox_attention(q, k_all, v_all, logf_all).reshape(b, L, FOX_WIDTH)
    xbc_c, conv_new = _causal_conv(xbc, conv_past, conv_w, conv_b)
    xbc_c = jax.nn.silu(xbc_c)
    xs, bm, cm = jnp.split(xbc_c, [SSM_INNER, SSM_INNER + SSM_GROUPS * SSM_STATE], axis=-1)
    dt = jax.nn.softplus(dt_raw.astype(jnp.float32) + dt_bias.astype(jnp.float32))
    A = -jnp.exp(a_log.astype(jnp.float32))
    y_ssm, ssm_new = _ssd(xs.reshape(b, L, SSM_HEADS, SSM_HEAD_DIM), dt, A,
                          bm.reshape(b, L, SSM_GROUPS, SSM_STATE), cm.reshape(b, L, SSM_GROUPS, SSM_STATE),
                          d_skip, ssm_past)
    y_ssm = y_ssm.reshape(b, L, SSM_INNER) * jax.nn.silu(z.astype(jnp.float32))
    y_ssm = y_ssm.reshape(b, L, SSM_GROUPS, SSM_INNER // SSM_GROUPS)
    y_ssm = y_ssm * lax.rsqrt(jnp.mean(y_ssm * y_ssm, axis=-1, keepdims=True) + EPS)
    y_ssm = (y_ssm.reshape(b, L, SSM_INNER) * ssm_norm_g.astype(jnp.float32)).astype(h.dtype)
    merged = jax.nn.sigmoid(ga) * y_att + jax.nn.sigmoid(gb) * y_ssm
    return merged @ w_out, k, v, logf, conv_new, ssm_new.astype(ssm_past.dtype)


def _layer(x, c, k_past, v_past, logf_past, conv_past, ssm_past,
           w_ada, b_ada, g_pre_mix, g_post_mix, g_pre_ffn, g_post_ffn,
           w_in, b_f, conv_w, conv_b, dt_bias, a_log, d_skip, ssm_norm_g, w_out, w_up, w_down):
    mod = jax.nn.silu(c) @ w_ada + b_ada
    sh1, sc1, gt1, sh2, sc2, gt2 = [m[:, None, :] for m in jnp.split(mod, N_MOD, axis=-1)]
    h = _rmsnorm(x, g_pre_mix) * (1 + sc1) + sh1
    m, k, v, logf, conv_new, ssm_new = _token_mixer(h, k_past, v_past, logf_past, conv_past, ssm_past,
                                                    w_in, b_f, conv_w, conv_b, dt_bias, a_log, d_skip,
                                                    ssm_norm_g, w_out)
    x = x + gt1 * _rmsnorm(m, g_post_mix)
    h = _rmsnorm(x, g_pre_ffn) * (1 + sc2) + sh2
    f = jnp.square(jax.nn.relu(h @ w_up)) @ w_down
    x = x + gt2 * _rmsnorm(f, g_post_ffn)
    return x, k, v, logf, conv_new, ssm_new


def setup_inputs(seed: int = 0) -> dict:
    key = jax.random.key(seed)
    ks = jax.random.split(key, 32)
    f32 = jnp.float32
    nrm = lambda k, shape, s: jax.random.normal(k, shape, f32) * s
    dt0 = jnp.exp(jax.random.uniform(ks[20], (DEPTH, SSM_HEADS), f32) * (np.log(0.1) - np.log(0.001)) + np.log(0.001))
    return {
        "x_prompt": nrm(ks[0], (BATCH, SEQ, D_MODEL), 1.0),
        "x_sample": nrm(ks[1], (DEC_BATCH, DEC_SEQ, D_MODEL), 1.0),
        "c_prompt": nrm(ks[2], (BATCH, D_MODEL), 1.0),
        "c_sample": nrm(ks[3], (DEC_BATCH, D_MODEL), 1.0),
        "cache_fox_k": nrm(ks[4], (DEPTH, DEC_BATCH, PAST_LEN, FOX_HEADS, FOX_HEAD_DIM), 1.0),
        "cache_fox_v": nrm(ks[5], (DEPTH, DEC_BATCH, PAST_LEN, FOX_HEADS, FOX_HEAD_DIM), 1.0),
        "cache_fox_logf": jax.nn.log_sigmoid(3.0 + nrm(ks[6], (DEPTH, DEC_BATCH, PAST_LEN, FOX_HEADS), 1.0)),
        "state_ssm_conv": nrm(ks[7], (DEPTH, DEC_BATCH, CONV_WIDTH - 1, CONV_DIM), 1.0),
        "state_ssm": nrm(ks[8], (DEPTH, DEC_BATCH, SSM_HEADS, SSM_HEAD_DIM, SSM_STATE), 0.1),
        "w_ada": nrm(ks[9], (DEPTH, D_MODEL, N_MOD * D_MODEL), 0.5 * D_MODEL ** -0.5),
        "b_ada": nrm(ks[10], (DEPTH, N_MOD * D_MODEL), 0.02),
        "g_pre_mix": 1.0 + nrm(ks[11], (DEPTH, D_MODEL), 0.05),
        "g_post_mix": 1.0 + nrm(ks[12], (DEPTH, D_MODEL), 0.05),
        "g_pre_ffn": 1.0 + nrm(ks[13], (DEPTH, D_MODEL), 0.05),
        "g_post_ffn": 1.0 + nrm(ks[14], (DEPTH, D_MODEL), 0.05),
        "w_in": nrm(ks[15], (DEPTH, D_MODEL, IN_WIDTH), D_MODEL ** -0.5),
        "b_f": 3.0 + nrm(ks[16], (DEPTH, FOX_HEADS), 0.5),
        "conv_w": nrm(ks[17], (DEPTH, CONV_WIDTH, CONV_DIM), CONV_WIDTH ** -0.5),
        "conv_b": nrm(ks[18], (DEPTH, CONV_DIM), 0.02),
        "dt_bias": dt0 + jnp.log(-jnp.expm1(-dt0)),
        "a_log": jnp.log(jax.random.uniform(ks[21], (DEPTH, SSM_HEADS), f32, 1.0, 16.0)),
        "d_skip": 1.0 + nrm(ks[22], (DEPTH, SSM_HEADS), 0.1),
        "ssm_norm_g": 1.0 + nrm(ks[23], (DEPTH, SSM_INNER), 0.05),
        "w_out": nrm(ks[24], (DEPTH, D_MODEL, D_MODEL), D_MODEL ** -0.5),
        "w_up": nrm(ks[25], (DEPTH, D_MODEL, D_FF), D_MODEL ** -0.5),
        "w_down": nrm(ks[26], (DEPTH, D_FF, D_MODEL), D_FF ** -0.5),
    }


def reference(x_prompt, x_sample, c_prompt, c_sample, cache_fox_k, cache_fox_v, cache_fox_logf,
              state_ssm_conv, state_ssm, w_ada, b_ada, g_pre_mix, g_post_mix, g_pre_ffn, g_post_ffn,
              w_in, b_f, conv_w, conv_b, dt_bias, a_log, d_skip, ssm_norm_g, w_out, w_up, w_down):
    bp = x_prompt.shape[0]
    empty_kv = jnp.zeros((bp, 0, FOX_HEADS, FOX_HEAD_DIM), x_prompt.dtype)
    empty_logf = jnp.zeros((bp, 0, FOX_HEADS), jnp.float32)
    zero_conv = jnp.zeros((bp, CONV_WIDTH - 1, CONV_DIM), x_prompt.dtype)
    zero_ssm = jnp.zeros((bp, SSM_HEADS, SSM_HEAD_DIM, SSM_STATE), jnp.float32)
    yp, ys = x_prompt, x_sample
    pk, pv, pl, pc, ps = [], [], [], [], []
    sk, sv, sl, sc, ss = [], [], [], [], []
    for i in range(DEPTH):
        lw = (w_ada[i], b_ada[i], g_pre_mix[i], g_post_mix[i], g_pre_ffn[i], g_post_ffn[i],
              w_in[i], b_f[i], conv_w[i], conv_b[i], dt_bias[i], a_log[i], d_skip[i], ssm_norm_g[i],
              w_out[i], w_up[i], w_down[i])
        yp, k1, v1, l1, c1, s1 = _layer(yp, c_prompt, empty_kv, empty_kv, empty_logf, zero_conv, zero_ssm, *lw)
        ys, k2, v2, l2, c2, s2 = _layer(ys, c_sample, cache_fox_k[i], cache_fox_v[i], cache_fox_logf[i],
                                        state_ssm_conv[i], state_ssm[i], *lw)
        pk.append(k1); pv.append(v1); pl.append(l1); pc.append(c1); ps.append(s1)
        sk.append(k2); sv.append(v2); sl.append(l2); sc.append(c2); ss.append(s2)
    prompt_fox_k = jnp.stack(pk)
    prompt_fox_v = jnp.stack(pv)
    prompt_fox_logf = jnp.stack(pl)
    prompt_ssm_conv = jnp.stack(pc)
    prompt_ssm = jnp.stack(ps)
    sample_fox_k = jnp.stack(sk)
    sample_fox_v = jnp.stack(sv)
    sample_fox_logf = jnp.stack(sl)
    sample_ssm_conv = jnp.stack(sc)
    sample_ssm = jnp.stack(ss)
    return (yp, ys, prompt_fox_k, prompt_fox_v, prompt_fox_logf, prompt_ssm_conv, prompt_ssm,
            sample_fox_k, sample_fox_v, sample_fox_logf, sample_ssm_conv, sample_ssm)
```

```cpp
#include <hip/hip_runtime.h>
#include <hip/hip_bf16.h>
#include <hip/hip_cooperative_groups.h>
#include <cstdio>
#include <cstdint>
namespace cg = cooperative_groups;

namespace pg8 {
#define PG8_LAS __attribute__((address_space(3)))
typedef unsigned short bf16_t;
typedef short bf16x8 __attribute__((ext_vector_type(8)));
typedef float f32x4 __attribute__((ext_vector_type(4)));
typedef unsigned u32x4 __attribute__((ext_vector_type(4)));
constexpr int BM = 256, BK = 64, HALF = 128, HTB = HALF * BK * 2  , STAGE_BYTES = 8 * HTB, NXCD = 8, WGM = 8;

__host__ __device__ __forceinline__ int lds_byte(int r, int c) { const int st = (r >> 4) * 2 + (c >> 5), rr = r & 15, cc = c & 31, ob = rr * 64 + cc * 2; return st * 1024 + (ob ^ (((ob >> 9) & 1) << 5)); }
__host__ __device__ __forceinline__ void stage_rc(int b, int& R, int& C) { const int st = b / 1024, sb = b % 1024, swz = sb ^ (((sb >> 9) & 1) << 5); R = (st >> 1) * 16 + swz / 64; C = (st & 1) * 32 + (swz % 64) / 2; }
__host__ __device__ __forceinline__ int perm32(int rho) { const int n = rho >> 4, i = rho & 15; return 8 * (i >> 2) + 4 * n + (i & 3); }

struct Unit { int pm, pn; };
struct Gemm { const bf16_t* A; const bf16_t* Bt; int M, N, K; };

struct StaticOrder {
    int nM, nN, nwg, G, c;
    __host__ __device__ void init(int M, int N, int G_, int c_) { nM = M / BM; nN = N / BM; nwg = nM * nN; G = G_; c = c_; }
    __host__ __device__ bool next(int i, Unit& u) const {
        const long L = (long)i * G + c; if (L >= nwg) return false;
        int wgid = (int)L; { const int q = nwg / NXCD, r = nwg % NXCD, xcd = wgid % NXCD, off = wgid / NXCD; wgid = (xcd < r ? xcd * (q + 1) : r * (q + 1) + (xcd - r) * q) + off; }
        const int nig = WGM * nN, gid = wgid / nig, fm = gid * WGM, gsz = (nM - fm) < WGM ? (nM - fm) : WGM;
        u.pm = fm + ((wgid % nig) % gsz); u.pn = (wgid % nig) / gsz; return true;
    }
    __device__ __forceinline__ void a_ready(const Unit&) const {}
    __device__ __forceinline__ void done(const Unit&) const {}
};

__device__ __forceinline__ unsigned cvt_pk_bf16(float lo, float hi) { unsigned r; asm volatile("v_cvt_pk_bf16_f32 %0, %1, %2" : "=v"(r) : "v"(lo), "v"(hi)); return r; }
template <class Epi, class Sched, bool ALIGN_EPI = false, bool SP2 = false>
__device__ __forceinline__ void gemm_phase(PG8_LAS unsigned char* lds, const Gemm g, const Sched& S, const Epi& E) {
    const int tid = threadIdx.x, wid = __builtin_amdgcn_readfirstlane(tid >> 6), lane = tid & 63, wr = wid >> 2, wc = wid & 3, fr = lane & 15, fq = lane >> 4;
    const int K = g.K, nt = K / BK;
    unsigned voffA[2], voffB[2];
#pragma unroll
    for (int i = 0; i < 2; ++i) { int R, C; stage_rc(tid * 16 + i * 8192, R, C); const int Rb = Epi::PERM ? ((R & ~31) + perm32(R & 31)) : R;
        voffA[i] = (unsigned)(R * K + C) * 2u; voffB[i] = (unsigned)(Rb * K + C) * 2u; }
    const size_t kstep = (size_t)(BK * 2);
    const size_t hstep = (size_t)HALF * K * 2;
    const size_t tstep = 2 * hstep;
    const unsigned ldsw = (unsigned)wid * 1024u;
    const int aoff = lds_byte(wr * 64 + fr, fq * 8), boff = lds_byte(wc * 32 + fr, fq * 8);
#define PG8_SA(b, h) (((b) * 2 + (h)) * HTB)
#define PG8_SB(b, h) ((4 + (b) * 2 + (h)) * HTB)
#define PG8_STAGE(bufoff, gbase, voff) do { _Pragma("unroll") for (int _i = 0; _i < 2; ++_i) \
        __builtin_amdgcn_global_load_lds((const unsigned*)((const char*)(gbase) + (voff)[_i]), (PG8_LAS unsigned*)(lds + (bufoff) + ldsw + _i * 8192), 16, 0, 0); } while (0)
#define PG8_LDA(dst, b, h) do { _Pragma("unroll") for (int m = 0; m < 4; ++m) _Pragma("unroll") for (int k = 0; k < 2; ++k) dst[m][k] = *(const PG8_LAS bf16x8*)(lds + PG8_SA(b, h) + aoff + m * 2048 + k * 1024); } while (0)
#define PG8_LDB(dst, b, h) do { _Pragma("unroll") for (int n = 0; n < 2; ++n) _Pragma("unroll") for (int k = 0; k < 2; ++k) dst[n][k] = *(const PG8_LAS bf16x8*)(lds + PG8_SB(b, h) + boff + n * 2048 + k * 1024); } while (0)
#define PG8_MMA(ai, bj, At, Bt) do { __builtin_amdgcn_s_setprio(1); _Pragma("unroll") for (int m = 0; m < 4; ++m) _Pragma("unroll") for (int n = 0; n < 2; ++n) _Pragma("unroll") for (int k = 0; k < 2; ++k) \
        acc[ai][bj][m][n] = __builtin_amdgcn_mfma_f32_16x16x32_bf16(Bt[n][k], At[m][k], acc[ai][bj][m][n], 0, 0, 0); __builtin_amdgcn_s_setprio(0); } while (0)
#define PG8_WAIT_V(n) asm volatile("s_waitcnt vmcnt(" #n ")" ::: "memory")
#define PG8_WAIT_L(n) asm volatile("s_waitcnt lgkmcnt(" #n ")" ::: "memory")
#define PG8_BAR __builtin_amdgcn_s_barrier()
#define PG8_SCHED __builtin_amdgcn_sched_barrier(0)
    Unit cur, nxt; int ui = 0;
    if (!S.next(0, cur)) return;
    f32x4 acc[2][2][4][2];
#pragma unroll
    for (int a = 0; a < 2; ++a)
#pragma unroll
        for (int b = 0; b < 2; ++b)
#pragma unroll
            for (int m = 0; m < 4; ++m)
#pragma unroll
                for (int n = 0; n < 2; ++n) acc[a][b][m][n] = (f32x4){0.f, 0.f, 0.f, 0.f};
    bf16x8 At[4][2], B0[2][2], B1[2][2];
    const char* cA = (const char*)g.A + (size_t)cur.pm * tstep; const char* cB = (const char*)g.Bt + (size_t)cur.pn * tstep;
    S.a_ready(cur);
    if constexpr (SP2) {
        PG8_STAGE(PG8_SB(0, 0), cB, voffB); PG8_STAGE(PG8_SB(0, 1), cB + hstep, voffB); PG8_STAGE(PG8_SA(0, 0), cA, voffA); PG8_STAGE(PG8_SA(0, 1), cA + hstep, voffA);
        if (wr == 1) PG8_BAR;
        PG8_WAIT_V(2); PG8_BAR;
        PG8_STAGE(PG8_SB(1, 0), cB + kstep, voffB); PG8_STAGE(PG8_SA(1, 0), cA + kstep, voffA); PG8_STAGE(PG8_SB(1, 1), cB + hstep + kstep, voffB);
        PG8_WAIT_V(6); PG8_BAR;
    } else {
        PG8_STAGE(PG8_SB(0, 0), cB, voffB); PG8_STAGE(PG8_SA(0, 0), cA, voffA); PG8_STAGE(PG8_SB(0, 1), cB + hstep, voffB); PG8_STAGE(PG8_SA(0, 1), cA + hstep, voffA);
        if (wr == 1) PG8_BAR;
        PG8_WAIT_V(4); PG8_BAR;
        PG8_STAGE(PG8_SB(1, 0), cB + kstep, voffB); PG8_STAGE(PG8_SA(1, 0), cA + kstep, voffA); PG8_STAGE(PG8_SB(1, 1), cB + hstep + kstep, voffB);
        PG8_WAIT_V(6); PG8_BAR;
    }
    for (;;) {
        const bool has_next = S.next(ui + 1, nxt);
        const char* nA = has_next ? (const char*)g.A + (size_t)nxt.pm * tstep : cA; const char* nB = has_next ? (const char*)g.Bt + (size_t)nxt.pn * tstep : cB;
        for (int t = 0; t < nt; t += 2) {
            const bool last = (t == nt - 2);
            const char* a1 = cA + (size_t)(t + 1) * kstep;
            const char* a2 = last ? nA : cA + (size_t)(t + 2) * kstep; const char* b2 = last ? nB : cB + (size_t)(t + 2) * kstep;
            const char* a3 = a2 + kstep; const char* b3 = b2 + kstep;
            if (last && has_next) S.a_ready(nxt);
            if constexpr (SP2) {
            PG8_LDB(B0, 0, 0); PG8_LDB(B1, 0, 1); PG8_SCHED; PG8_LDA(At, 0, 0); PG8_STAGE(PG8_SA(1, 1), a1 + hstep, voffA);
            PG8_WAIT_V(8); PG8_WAIT_L(0); PG8_BAR; PG8_MMA(0, 0, At, B0); PG8_MMA(0, 1, At, B1); PG8_BAR; PG8_SCHED;
            PG8_LDA(At, 0, 1); PG8_STAGE(PG8_SB(0, 0), b2, voffB); PG8_STAGE(PG8_SB(0, 1), b2 + hstep, voffB); PG8_STAGE(PG8_SA(0, 0), a2, voffA);
            PG8_WAIT_V(8); PG8_WAIT_L(0); PG8_BAR; PG8_MMA(1, 0, At, B0); PG8_MMA(1, 1, At, B1); PG8_BAR; PG8_SCHED;
            PG8_LDB(B0, 1, 0); PG8_LDB(B1, 1, 1); PG8_SCHED; PG8_LDA(At, 1, 0); PG8_STAGE(PG8_SA(0, 1), a2 + hstep, voffA);
            PG8_WAIT_V(8); PG8_WAIT_L(0); PG8_BAR; PG8_MMA(0, 0, At, B0); PG8_MMA(0, 1, At, B1); PG8_BAR; PG8_SCHED;
            PG8_LDA(At, 1, 1); PG8_STAGE(PG8_SB(1, 0), b3, voffB); PG8_STAGE(PG8_SB(1, 1), b3 + hstep, voffB); PG8_STAGE(PG8_SA(1, 0), a3, voffA);
            PG8_WAIT_V(8); PG8_WAIT_L(0); PG8_BAR; PG8_MMA(1, 0, At, B0); PG8_MMA(1, 1, At, B1); PG8_BAR; PG8_SCHED;
            } else {
            PG8_LDB(B0, 0, 0); PG8_SCHED; PG8_LDA(At, 0, 0); PG8_STAGE(PG8_SA(1, 1), a1 + hstep, voffA);
            PG8_WAIT_L(8); PG8_BAR; PG8_WAIT_L(0); PG8_MMA(0, 0, At, B0); PG8_BAR; PG8_SCHED;
            PG8_LDB(B1, 0, 1); PG8_STAGE(PG8_SB(0, 0), b2, voffB);
            PG8_BAR; PG8_WAIT_L(0); PG8_MMA(0, 1, At, B1); PG8_BAR;
            PG8_LDA(At, 0, 1); PG8_STAGE(PG8_SA(0, 0), a2, voffA);
            PG8_BAR; PG8_WAIT_L(0); PG8_MMA(1, 0, At, B0); PG8_BAR; PG8_SCHED;
            PG8_STAGE(PG8_SB(0, 1), b2 + hstep, voffB);
            PG8_WAIT_V(6); PG8_BAR; PG8_MMA(1, 1, At, B1); PG8_BAR;
            PG8_LDB(B0, 1, 0); PG8_SCHED; PG8_LDA(At, 1, 0); PG8_STAGE(PG8_SA(0, 1), a2 + hstep, voffA);
            PG8_WAIT_L(8); PG8_BAR; PG8_WAIT_L(0); PG8_MMA(0, 0, At, B0); PG8_BAR; PG8_SCHED;
            PG8_LDB(B1, 1, 1); PG8_STAGE(PG8_SB(1, 0), b3, voffB);
            PG8_BAR; PG8_WAIT_L(0); PG8_MMA(0, 1, At, B1); PG8_BAR;
            PG8_LDA(At, 1, 1); PG8_STAGE(PG8_SA(1, 0), a3, voffA);
            PG8_BAR; PG8_WAIT_L(0); PG8_MMA(1, 0, At, B0); PG8_BAR; PG8_SCHED;
            PG8_STAGE(PG8_SB(1, 1), b3 + hstep, voffB);
            PG8_WAIT_V(6); PG8_BAR; PG8_MMA(1, 1, At, B1); PG8_BAR;
            }
        }
        if constexpr (ALIGN_EPI) { if (wr == 0) PG8_BAR; }
        if constexpr (!Epi::AFTER_DRAIN) { E(acc, cur, wr, wc, fr, fq); S.done(cur); }
        if (!has_next) break;
#pragma unroll
        for (int a = 0; a < 2; ++a)
#pragma unroll
            for (int b = 0; b < 2; ++b)
#pragma unroll
                for (int m = 0; m < 4; ++m)
#pragma unroll
                    for (int n = 0; n < 2; ++n) acc[a][b][m][n] = (f32x4){0.f, 0.f, 0.f, 0.f};
        cur = nxt; cA = nA; cB = nB; ++ui;
        if constexpr (ALIGN_EPI) { if (wr == 1) PG8_BAR; }
    }
    PG8_WAIT_V(0);
    if constexpr (!ALIGN_EPI) { if (wr == 0) PG8_BAR; }
    PG8_BAR;
    if constexpr (Epi::AFTER_DRAIN) { E.fused(acc, cur, wr, wc, fr, fq, lds, wid, lane); S.done(cur); }
#undef PG8_SA
#undef PG8_SB
#undef PG8_STAGE
#undef PG8_LDA
#undef PG8_LDB
#undef PG8_MMA
#undef PG8_WAIT_V
#undef PG8_WAIT_L
#undef PG8_BAR
#undef PG8_SCHED
}
}

constexpr int DM = 1024, SEQ = 16384, NSB = 16, NSL = 16, PAST = 1024, NSR = NSB * NSL  , R = SEQ + NSR  ;
constexpr int NH = 8, HD = 128, SH = 16, SP = 64, SG = 4, SN = 128, CONVD = 2048, DFF = 4096;
constexpr int NIN = 8448;
constexpr int TKS = PAST + NSL;
constexpr float EPS = 1e-6f;
constexpr float FOX_SCALE = 0.08838834764831845f, INV_SCALE = 11.313708498984761f;
constexpr size_t O_YP = 0, O_YS = O_YP + (size_t)SEQ * DM, O_PK = O_YS + (size_t)NSR * DM, O_PV = O_PK + (size_t)SEQ * DM, O_PL = O_PV + (size_t)SEQ * DM,
                 O_PC = O_PL + (size_t)SEQ * NH, O_PS = O_PC + 3 * CONVD, O_SK = O_PS + (size_t)SH * SP * SN, O_SV = O_SK + (size_t)NSR * DM, O_SL = O_SV + (size_t)NSR * DM,
                 O_SC = O_SL + (size_t)NSR * NH, O_SS = O_SC + (size_t)NSB * 3 * CONVD, O_END = O_SS + (size_t)NSB * SH * SP * SN;
static_assert(O_END == 53583872, "output size");
constexpr size_t WS_WTIN = 0, WS_WTOUT = WS_WTIN + (size_t)NIN * DM * 2, WS_WTUP = WS_WTOUT + (size_t)DM * DM * 2, WS_WTDN = WS_WTUP + (size_t)DFF * DM * 2,
                 WS_MOD = WS_WTDN + (size_t)DM * DFF * 2, WS_LOGF = WS_MOD + 17 * 6144 * 4, WS_DT = WS_LOGF + (size_t)R * 8 * 4, WS_FSP = WS_DT + (size_t)R * 16 * 4,
                 WS_FSS = WS_FSP + (size_t)NH * SEQ * 4, WS_GAS = WS_FSS + (size_t)128 * TKS * 4, WS_GBS = WS_GAS + (size_t)NSR * DM * 2, WS_H = WS_GBS + (size_t)NSR * DM * 2,
                 WS_Q = WS_H + (size_t)R * DM * 2, WS_K = WS_Q + (size_t)R * DM * 2, WS_V = WS_K + (size_t)R * DM * 2, WS_Z = WS_V + (size_t)R * DM * 2,
                 WS_XBC = WS_Z + (size_t)R * DM * 2, WS_CDEC = WS_XBC + (size_t)R * CONVD * 2, WS_NRM = WS_CDEC + 256 * 16 * 4, WS_BAR = WS_NRM + 256, WS_GQ = WS_BAR + 16384, WS_GD = WS_GQ + (size_t)NH * SEQ * 4, WS_LOGFT = WS_GD + (size_t)NH * SEQ * 4, WS_END = WS_LOGFT + (size_t)NH * SEQ * 4;
constexpr size_t WS_ST = WS_K;
static_assert((size_t)256 * 16 * 64 * 128 * 2 <= WS_Z - WS_K, "state overlay");
constexpr size_t WS_YS = WS_Q;
constexpr size_t WS_HID = WS_Q;
constexpr size_t WS_MF = WS_XBC;
static_assert(WS_MOD % 256 == 0 && WS_H % 256 == 0 && WS_FSS % 256 == 0 && WS_GAS % 256 == 0, "align");
constexpr int LDS_BYTES = 147456;
constexpr int NTHR = 512, NWV = 8;

#define LAS __attribute__((address_space(3)))
typedef unsigned short bf16_t;
typedef float f32x4 __attribute__((ext_vector_type(4)));
typedef unsigned u32x4 __attribute__((ext_vector_type(4)));
typedef unsigned u32x2 __attribute__((ext_vector_type(2)));
typedef short bf16x8 __attribute__((ext_vector_type(8)));

__device__ __forceinline__ unsigned pk2(float lo, float hi) { return pg8::cvt_pk_bf16(lo, hi); }
__device__ __forceinline__ float bf2f(unsigned short b) { return __uint_as_float(((unsigned)b) << 16); }
__device__ __forceinline__ float bflo(unsigned w) { return __uint_as_float(w << 16); }
__device__ __forceinline__ float bfhi(unsigned w) { return __uint_as_float(w & 0xffff0000u); }
__device__ __forceinline__ float wave_sum(float v) {
#pragma unroll
    for (int o = 1; o < 64; o <<= 1) v += __shfl_xor(v, o);
    return v;
}
__device__ __forceinline__ float sigmoidf_(float x) { return __builtin_amdgcn_rcpf(1.f + __expf(-x)); }
__device__ __forceinline__ float siluf_(float x) { return x * __builtin_amdgcn_rcpf(1.f + __expf(-x)); }
__device__ __forceinline__ float softplusf_(float x) { return fmaxf(x, 0.f) + __logf(1.f + __expf(-fabsf(x))); }
__device__ __forceinline__ float logsigmoidf_(float x) { return fminf(x, 0.f) - __logf(1.f + __expf(-fabsf(x))); }

struct Params { const float* in[26]; float* out; unsigned char* ws; int ph_lo, ph_hi; };
typedef const __attribute__((address_space(4))) Params* PP;
__device__ __forceinline__ PP kparams() { PP q = (PP)__builtin_amdgcn_kernarg_segment_ptr(); asm volatile("" : "+s"(q)); return q; }
__device__ __forceinline__ bool in_phase(int k) { PP q = kparams(); return q->ph_lo <= k && k < q->ph_hi; }
__device__ __forceinline__ int launder_tid() { int t = threadIdx.x; asm volatile("" : "+v"(t)); return t; }
enum { I_XP = 0, I_XS, I_CP, I_CS, I_CK, I_CV, I_CLF, I_SCONV, I_SSM, I_WADA, I_BADA, I_GPM, I_GQM, I_GPF, I_GQF, I_WIN, I_BF, I_CW, I_CB, I_DTB, I_ALOG, I_DSKIP, I_SNG, I_WOUT, I_WUP, I_WDN };

namespace pg8 {
struct EpiIn {
    static constexpr bool PERM = true, AFTER_DRAIN = false;
    int dummy;
    __device__ __forceinline__ void operator()(const f32x4 (&acc)[2][2][4][2], const Unit& u, int wr, int wc, int fr, int fq) const {
        const int pn = u.pn;
        const int seg = pn < 16 ? (pn >> 2) : (pn < 24 ? 4 : (pn < 28 ? 5 : (pn < 32 ? 6 : 7)));
        switch (seg) {
            case 0: body<0>(acc, u, wr, wc, fr, fq); break; case 1: body<1>(acc, u, wr, wc, fr, fq); break; case 2: body<2>(acc, u, wr, wc, fr, fq); break; case 3: body<3>(acc, u, wr, wc, fr, fq); break;
            case 4: body<4>(acc, u, wr, wc, fr, fq); break; case 5: body<5>(acc, u, wr, wc, fr, fq); break; case 6: body<6>(acc, u, wr, wc, fr, fq); break; default: body<7>(acc, u, wr, wc, fr, fq); break; }
    }
    template <int seg>
    __device__ __forceinline__ void body(const f32x4 (&acc)[2][2][4][2], const Unit& u, int wr, int wc, int fr, int fq) const {
        PP pq = kparams(); unsigned char* ws = pq->ws; float* out = pq->out; const float* b_f = pq->in[I_BF]; const float* dt_bias = pq->in[I_DTB];
        const int pn = u.pn;
        constexpr int segbase = seg < 4 ? seg * 1024 : (seg == 4 ? 4096 : (seg == 5 ? 6144 : (seg == 6 ? 7168 : 8192)));
#pragma unroll
        for (int ai = 0; ai < 2; ++ai)
#pragma unroll
            for (int m = 0; m < 4; ++m) {
                const int row = u.pm * BM + ai * HALF + wr * 64 + m * 16 + fr;
                const bool smp = row >= SEQ; const int srow = row - SEQ;
#pragma unroll
                for (int bj = 0; bj < 2; ++bj) {
                    const int c = pn * BM + bj * HALF + wc * 32 + 8 * fq - segbase;
                    const f32x4 v0 = acc[ai][bj][m][0], v1 = acc[ai][bj][m][1];
                    u32x4 w; w.x = cvt_pk_bf16(v0[0], v0[1]); w.y = cvt_pk_bf16(v0[2], v0[3]); w.z = cvt_pk_bf16(v1[0], v1[1]); w.w = cvt_pk_bf16(v1[2], v1[3]);
                    if (seg == 0) { *(u32x4*)((bf16_t*)(ws + WS_Q) + (size_t)row * DM + c) = w; }
                    else if (seg == 1 || seg == 2) {
                        *(u32x4*)((bf16_t*)(ws + (seg == 1 ? WS_K : WS_V)) + (size_t)row * DM + c) = w;
                        float* o = smp ? out + (seg == 1 ? O_SK : O_SV) + (size_t)srow * DM + c : out + (seg == 1 ? O_PK : O_PV) + (size_t)row * DM + c;
                        *(f32x4*)o = v0; *(f32x4*)(o + 4) = v1;
                    }
                    else if (seg == 3) { *(u32x4*)((bf16_t*)(ws + WS_Z) + (size_t)row * DM + c) = w; }
                    else if (seg == 4) {
                        *(u32x4*)((bf16_t*)(ws + WS_XBC) + (size_t)row * CONVD + c) = w;
                        if (!smp) { if (row >= SEQ - 3) { float* o = out + O_PC + (size_t)(row - (SEQ - 3)) * CONVD + c; *(f32x4*)o = v0; *(f32x4*)(o + 4) = v1; } }
                        else { const int i = srow & 15, b = srow >> 4; if (i >= 13) { float* o = out + O_SC + (size_t)(b * 3 + i - 13) * CONVD + c; *(f32x4*)o = v0; *(f32x4*)(o + 4) = v1; } }
                    }
                    else if (seg == 5 || seg == 6) {
                        bf16_t* d = smp ? (bf16_t*)(ws + (seg == 5 ? WS_GAS : WS_GBS)) + (size_t)srow * DM + c
                                        : (bf16_t*)(out + O_YP) + (seg == 5 ? (size_t)0 : (size_t)SEQ * DM) + (size_t)row * DM + c;
                        *(u32x4*)d = w;
                    }
                    else {
                        if (c == 0) {
                            float lf[8];
#pragma unroll
                            for (int j = 0; j < 4; ++j) { lf[j] = logsigmoidf_(v0[j] + b_f[j]); lf[4 + j] = logsigmoidf_(v1[j] + b_f[4 + j]); }
                            float* o1 = (float*)(ws + WS_LOGF) + (size_t)row * 8; float* o2 = smp ? out + O_SL + (size_t)srow * 8 : out + O_PL + (size_t)row * 8;
                            *(f32x4*)o1 = (f32x4){lf[0], lf[1], lf[2], lf[3]}; *(f32x4*)(o1 + 4) = (f32x4){lf[4], lf[5], lf[6], lf[7]};
                            *(f32x4*)o2 = (f32x4){lf[0], lf[1], lf[2], lf[3]}; *(f32x4*)(o2 + 4) = (f32x4){lf[4], lf[5], lf[6], lf[7]};
                            if (!smp) { float* ot = (float*)(ws + WS_LOGFT) + row;
#pragma unroll
                                for (int j = 0; j < 8; ++j) ot[(size_t)j * SEQ] = lf[j]; }
                        } else if (c == 8 || c == 16) {
                            float d[8];
#pragma unroll
                            for (int j = 0; j < 4; ++j) { d[j] = softplusf_(v0[j] + dt_bias[c - 8 + j]); d[4 + j] = softplusf_(v1[j] + dt_bias[c - 8 + 4 + j]); }
                            float* o1 = (float*)(ws + WS_DT) + (size_t)row * 16 + (c - 8);
                            *(f32x4*)o1 = (f32x4){d[0], d[1], d[2], d[3]}; *(f32x4*)(o1 + 4) = (f32x4){d[4], d[5], d[6], d[7]};
                        }
                    }
                }
            }
    }
};
struct EpiF32 {
    static constexpr bool PERM = false, AFTER_DRAIN = false;
    float* O; int ldc;
    __device__ __forceinline__ void operator()(const f32x4 (&acc)[2][2][4][2], const Unit& u, int wr, int wc, int fr, int fq) const {
#pragma unroll
        for (int ai = 0; ai < 2; ++ai)
#pragma unroll
            for (int m = 0; m < 4; ++m) { float* rowp = O + (size_t)(u.pm * BM + ai * HALF + wr * 64 + m * 16 + fr) * ldc + u.pn * BM + wc * 32 + 4 * fq;
#pragma unroll
                for (int bj = 0; bj < 2; ++bj)
#pragma unroll
                    for (int n = 0; n < 2; ++n) *(f32x4*)(rowp + bj * HALF + n * 16) = acc[ai][bj][m][n]; }
    }
};
struct EpiBf {
    static constexpr bool PERM = true, AFTER_DRAIN = false;
    bf16_t* O; int ldc;
    __device__ __forceinline__ void operator()(const f32x4 (&acc)[2][2][4][2], const Unit& u, int wr, int wc, int fr, int fq) const {
#pragma unroll
        for (int ai = 0; ai < 2; ++ai)
#pragma unroll
            for (int m = 0; m < 4; ++m) { bf16_t* rowp = O + (size_t)(u.pm * BM + ai * HALF + wr * 64 + m * 16 + fr) * ldc + u.pn * BM + wc * 32 + 8 * fq;
#pragma unroll
                for (int bj = 0; bj < 2; ++bj) { const f32x4 v0 = acc[ai][bj][m][0], v1 = acc[ai][bj][m][1];
                    u32x4 w; w.x = cvt_pk_bf16(v0[0], v0[1]); w.y = cvt_pk_bf16(v0[2], v0[3]); w.z = cvt_pk_bf16(v1[0], v1[1]); w.w = cvt_pk_bf16(v1[2], v1[3]);
                    *(u32x4*)(rowp + bj * HALF) = w; } }
    }
};
struct EpiRelu2 {
    static constexpr bool PERM = true, AFTER_DRAIN = false;
    bf16_t* O; int ldc;
    __device__ __forceinline__ void operator()(const f32x4 (&acc)[2][2][4][2], const Unit& u, int wr, int wc, int fr, int fq) const {
#pragma unroll
        for (int ai = 0; ai < 2; ++ai)
#pragma unroll
            for (int m = 0; m < 4; ++m) { bf16_t* rowp = O + (size_t)(u.pm * BM + ai * HALF + wr * 64 + m * 16 + fr) * ldc + u.pn * BM + wc * 32 + 8 * fq;
#pragma unroll
                for (int bj = 0; bj < 2; ++bj) { f32x4 v0 = acc[ai][bj][m][0], v1 = acc[ai][bj][m][1];
#pragma unroll
                    for (int j = 0; j < 4; ++j) { const float a = fmaxf(v0[j], 0.f), b = fmaxf(v1[j], 0.f); v0[j] = a * a; v1[j] = b * b; }
                    u32x4 w; w.x = cvt_pk_bf16(v0[0], v0[1]); w.y = cvt_pk_bf16(v0[2], v0[3]); w.z = cvt_pk_bf16(v1[0], v1[1]); w.w = cvt_pk_bf16(v1[2], v1[3]);
                    *(u32x4*)(rowp + bj * HALF) = w; } }
    }
};
}

namespace att {
constexpr int D = 128, LD = 1024;
constexpr float SCALE = 0.08838834764831845f;
constexpr float THR = 8.f;
constexpr bool WSKIP = false;
constexpr int NW = 8, QBLK = 32, KVBLK = 64, QB = NW * QBLK;
constexpr int SHM_V = KVBLK * D * 2, SHM_K = KVBLK * D * 2;
constexpr int ATT_LDS = 2 * SHM_V + 2 * SHM_K + NW * 64 * 4;
constexpr int FT_OFF = 73728;
using bf16 = __hip_bfloat16;
typedef short bf16x8 __attribute__((ext_vector_type(8)));
typedef short s16x4 __attribute__((ext_vector_type(4)));
typedef float f32x16 __attribute__((ext_vector_type(16)));
typedef float f32x4 __attribute__((ext_vector_type(4)));
typedef unsigned u32x4 __attribute__((ext_vector_type(4)));
template <class A, class Bt> struct same_t { static constexpr bool v = false; };
template <class A> struct same_t<A, A> { static constexpr bool v = true; };

#define KSWZ(row, colB) ((row) * 256 + ((colB) ^ (((row) & 7) << 4)))
#define SBAR() __builtin_amdgcn_sched_barrier(0)
__device__ __forceinline__ int v_st(int k, int c) { const int kk = (k & ~0xC) | ((k & 4) << 1) | ((k & 8) >> 1); return ((kk >> 3) * 4 + (c >> 5)) * 512 + ((kk & 7) * 32 + (c & 31)) * 2; }
__device__ __forceinline__ int v_rd_base(int lane) { return ((lane & 3) << 3) | (((lane >> 2) & 3) << 6) | (((lane >> 4) & 1) << 5) | (((lane >> 5) & 1) << 8); }
constexpr int v_rd_off(int d0, int ks, int half) { return d0 * 512 + ks * 4096 + half * 2048; }
__device__ __forceinline__ int crow(int r, int hi) { return (r & 3) + 8 * (r >> 2) + 4 * hi; }
__device__ __forceinline__ unsigned cvtpk(float lo, float hi) {
    unsigned r; asm volatile("v_cvt_pk_bf16_f32 %0, %1, %2" : "=v"(r) : "v"(lo), "v"(hi)); return r;
}
__device__ __forceinline__ bf16x8 pack8(f32x4 a, f32x4 b) {
    u32x4 w = {cvtpk(a[0], a[1]), cvtpk(a[2], a[3]), cvtpk(b[0], b[1]), cvtpk(b[2], b[3])};
    return *reinterpret_cast<bf16x8*>(&w);
}
template <class T> __device__ __forceinline__ bf16x8 load8(const T* p) {
    if constexpr (same_t<T, float>::v) { return pack8(*(const f32x4*)p, *(const f32x4*)(p + 4)); }
    else { return *reinterpret_cast<const bf16x8*>(p); }
}
__device__ __forceinline__ void mask_tile(f32x16& p0, f32x16& p1, int dq, unsigned W) {
    const float NEG = -__builtin_inff();
#pragma unroll
    for (int r = 0; r < 16; ++r) {
        const int c = (r & 3) + 8 * (r >> 2);
        if ((unsigned)(dq - c) >= W) p0[r] = NEG;
        if ((unsigned)(dq - c - 32) >= W) p1[r] = NEG;
    }
}
__device__ __forceinline__ void partialSM(f32x16& p0, f32x16& p1, float& m_reg, float& mn, float& alpha) {
    float pmax = p0[0]; for (int r = 1; r < 16; ++r) pmax = fmaxf(pmax, p0[r]); for (int r = 0; r < 16; ++r) pmax = fmaxf(pmax, p1[r]);
    { auto rr = __builtin_amdgcn_permlane32_swap(__float_as_uint(pmax), __float_as_uint(pmax), false, false);
      pmax = fmaxf(__uint_as_float(rr[0]), __uint_as_float(rr[1])); }
    constexpr float C2 = 1.4426950408889634f * SCALE;
    if (__builtin_expect(__all((pmax - m_reg) * SCALE <= THR), 1)) { mn = m_reg; alpha = 1.f; }
    else { mn = fmaxf(m_reg, pmax); alpha = __builtin_amdgcn_exp2f((m_reg - mn) * C2); m_reg = mn; }
    const float mnL = -mn * C2;
    for (int r = 0; r < 16; ++r) p0[r] = fmaf(p0[r], C2, mnL); for (int r = 0; r < 16; ++r) p1[r] = fmaf(p1[r], C2, mnL);
    for (int r = 0; r < 16; ++r) p0[r] = __builtin_amdgcn_exp2f(p0[r]);
}
__device__ __forceinline__ void finishSM(f32x16& p0, f32x16& p1, float alpha, float& l_reg, bf16x8& pa0, bf16x8& pa1, bf16x8& pa2, bf16x8& pa3) {
    for (int r = 0; r < 16; ++r) p1[r] = __builtin_amdgcn_exp2f(p1[r]);
    float ps = 0; for (int r = 0; r < 16; ++r) ps += p0[r]; for (int r = 0; r < 16; ++r) ps += p1[r];
    { auto rr = __builtin_amdgcn_permlane32_swap(__float_as_uint(ps), __float_as_uint(ps), false, false);
      ps = __uint_as_float(rr[0]) + __uint_as_float(rr[1]); }
    l_reg = l_reg * alpha + ps;
#define PK4(P, B_, OUT) do { unsigned a0 = cvtpk(P[B_+0], P[B_+1]), a1 = cvtpk(P[B_+2], P[B_+3]);                          \
        unsigned b0 = cvtpk(P[B_+4], P[B_+5]), b1 = cvtpk(P[B_+6], P[B_+7]);                                             \
        auto r0 = __builtin_amdgcn_permlane32_swap(a0, b0, false, false); auto r1 = __builtin_amdgcn_permlane32_swap(a1, b1, false, false); \
        u32x4 w = {r0[0], r1[0], r0[1], r1[1]}; OUT = *reinterpret_cast<bf16x8*>(&w); } while (0)
    PK4(p0, 0, pa0); PK4(p0, 8, pa1); PK4(p1, 0, pa2); PK4(p1, 8, pa3);
#undef PK4
}
template <int KB, bool SK>
__device__ __forceinline__ void qkt(f32x16& p0, f32x16& p1, const char* K_lds, int r32, int hi, const bf16x8* qr, bool act, const float* FTk) {
    if (SK && !act) { const float NEG = -__builtin_inff();
#pragma unroll
        for (int r = 0; r < 16; ++r) { p0[r] = NEG; p1[r] = NEG; } return; }
    { const f32x4* fb = (const f32x4*)FTk + hi;
#pragma unroll
      for (int i = 0; i < 4; ++i) { const f32x4 f0 = fb[2 * i], f1 = fb[8 + 2 * i];
#pragma unroll
        for (int j = 0; j < 4; ++j) { p0[4 * i + j] = f0[j]; p1[4 * i + j] = f1[j]; } } }
    const char* kb[4];
#pragma unroll
    for (int dd = 0; dd < 4; ++dd) kb[dd] = K_lds + KB * SHM_K + KSWZ(r32, (dd * 16 + hi * 8) * 2);
#pragma unroll
    for (int d0 = 0; d0 < 8; ++d0) { const char* a = kb[d0 & 3] + (d0 >> 2) * 128;
        bf16x8 b0 = *reinterpret_cast<const bf16x8*>(a);
        bf16x8 b1 = *reinterpret_cast<const bf16x8*>(a + 32 * 256);
        p0 = __builtin_amdgcn_mfma_f32_32x32x16_bf16(b0, qr[d0], p0, 0, 0, 0);
        p1 = __builtin_amdgcn_mfma_f32_32x32x16_bf16(b1, qr[d0], p1, 0, 0, 0); }
}
template <int VB, bool SK>
__device__ __forceinline__ void pv_tile(f32x16* o, int vb0, bf16x8 pa0, bf16x8 pa1, bf16x8 pa2, bf16x8 pa3, bool act) {
    if (SK && !act) return;
#define TRRD(dst, off) asm volatile("ds_read_b64_tr_b16 %0, %1 offset:%2" : "=&v"(dst) : "v"(vb0), "i"(off) : "memory")
#define PV_D0(d0) do { s16x4 l0, l1, l2, l3, h0, h1, h2, h3; constexpr int b_ = VB * SHM_V + v_rd_off(d0, 0, 0);     \
        TRRD(l0, b_); TRRD(h0, b_ + 2048); TRRD(l1, b_ + 4096); TRRD(h1, b_ + 6144); TRRD(l2, b_ + 8192); TRRD(h2, b_ + 10240); TRRD(l3, b_ + 12288); TRRD(h3, b_ + 14336); \
        asm volatile("s_waitcnt lgkmcnt(0)" ::: "memory"); SBAR();                 \
        o[d0] = __builtin_amdgcn_mfma_f32_32x32x16_bf16(pa0, (bf16x8){l0[0], l0[1], l0[2], l0[3], h0[0], h0[1], h0[2], h0[3]}, o[d0], 0, 0, 0);   \
        o[d0] = __builtin_amdgcn_mfma_f32_32x32x16_bf16(pa1, (bf16x8){l1[0], l1[1], l1[2], l1[3], h1[0], h1[1], h1[2], h1[3]}, o[d0], 0, 0, 0);   \
        o[d0] = __builtin_amdgcn_mfma_f32_32x32x16_bf16(pa2, (bf16x8){l2[0], l2[1], l2[2], l2[3], h2[0], h2[1], h2[2], h2[3]}, o[d0], 0, 0, 0);   \
        o[d0] = __builtin_amdgcn_mfma_f32_32x32x16_bf16(pa3, (bf16x8){l3[0], l3[1], l3[2], l3[3], h3[0], h3[1], h3[2], h3[3]}, o[d0], 0, 0, 0); } while (0)
    PV_D0(0); PV_D0(1); PV_D0(2); PV_D0(3);
#undef PV_D0
#undef TRRD
}

template <class TIn, class TOut> struct BlockRef { const TIn* Q; const TIn* K; const TIn* V; TOut* O; const float* F; int P0; int jlo; };
template <class TIn> struct Seam {
    bf16x8 qr[8];
    bf16x8 st_v0, st_v1, st_k0, st_k1; f32x4 sf0, sf1, sf2, sf3;
    f32x4 tq[16];
};
__device__ __forceinline__ int swa_jlo(int P0, int W) { const int lowk = P0 - W + 1; return lowk > 0 ? lowk / KVBLK : 0; }
#define ROW(p, k0, rr) ((p) + (size_t)(k0) * LD + (unsigned)((rr) * LD + sc))
#define VMW() asm volatile("s_waitcnt vmcnt(0)" ::: "memory")
#define VMWN(n) asm volatile("s_waitcnt vmcnt(%0)" :: "i"(n) : "memory")
#define SLOAD_H(Kp, Vp, Fp, k0) do { S.st_v0 = load8<TIn>(ROW(Vp, k0, sr)); S.st_v1 = load8<TIn>(ROW(Vp, k0, 32 + sr));              \
                         S.st_k0 = load8<TIn>(ROW(Kp, k0, sr)); S.st_k1 = load8<TIn>(ROW(Kp, k0, 32 + sr)); } while (0)
#define SWRITE_HK(bf) do { *(bf16x8*)(K_lds + (bf) * SHM_K + kws) = S.st_k0; *(bf16x8*)(K_lds + (bf) * SHM_K + kws + 32 * 256) = S.st_k1; } while (0)
#define SWRITE_HV(bf) do { *(bf16x8*)(V_lds + (bf) * SHM_V + vst0) = S.st_v0; *(bf16x8*)(V_lds + (bf) * SHM_V + vst1) = S.st_v1; } while (0)
#define SWRITE_H(bf) do { SWRITE_HV(bf); SWRITE_HK(bf); } while (0)
#define SLOAD_F(p, k0) do { S.sf0 = *(const f32x4*)ROW(p, k0, sr); S.sf1 = *(const f32x4*)(ROW(p, k0, sr) + 4);                \
                            S.sf2 = *(const f32x4*)ROW(p, k0, 32 + sr); S.sf3 = *(const f32x4*)(ROW(p, k0, 32 + sr) + 4); } while (0)
#define SWRITE_KF(bf) do { *(bf16x8*)(K_lds + (bf) * SHM_K + kws) = pack8(S.sf0, S.sf1); *(bf16x8*)(K_lds + (bf) * SHM_K + kws + 32 * 256) = pack8(S.sf2, S.sf3); } while (0)
#define SWRITE_VF(bf) do { *(bf16x8*)(V_lds + (bf) * SHM_V + vst0) = pack8(S.sf0, S.sf1); *(bf16x8*)(V_lds + (bf) * SHM_V + vst1) = pack8(S.sf2, S.sf3); } while (0)
template <class TIn, class TOut>
__device__ __forceinline__ void causal_swa_prime(const BlockRef<TIn, TOut>& cur, int W, char* lds, Seam<TIn>& S) {
    constexpr bool F32 = same_t<TIn, float>::v;
    const int tid = threadIdx.x, wid = __builtin_amdgcn_readfirstlane(tid >> 6), lane = tid & 63, r32 = lane & 31, hi = lane >> 5;
    const int sr = tid >> 4, sc = (tid & 15) * 8, kws = KSWZ(sr, sc * 2); char* K_lds = lds + 2 * SHM_V;
    const int kb0 = cur.jlo * KVBLK;
    for (int d0 = 0; d0 < 8; ++d0) S.qr[d0] = load8<TIn>(cur.Q + (size_t)(wid * QBLK + r32) * LD + d0 * 16 + hi * 8);
    if constexpr (F32) { SLOAD_F((const float*)cur.K, kb0); VMW(); SWRITE_KF(0); SBAR(); SLOAD_F((const float*)cur.V, kb0); }
    else { SLOAD_H(cur.K, cur.V, cur.F, kb0); VMW(); SWRITE_HK(0); }
    __syncthreads();
}
template <class TIn, class TOut>
__device__ __forceinline__ void causal_swa_block(const BlockRef<TIn, TOut>& cur, const BlockRef<TIn, TOut>& nxt, int skv, int W, char* lds, Seam<TIn>& S) {
    constexpr bool F32 = same_t<TIn, float>::v;
    const int tid = threadIdx.x, wid = __builtin_amdgcn_readfirstlane(tid >> 6), lane = tid & 63, r32 = lane & 31, hi = lane >> 5;
    const int j_lo = cur.jlo;
    int j_hi = (cur.P0 + QB - 1) / KVBLK + 1; if (j_hi > skv / KVBLK) j_hi = skv / KVBLK;
    const int NT = j_hi - j_lo;
    const int kbn = nxt.jlo * KVBLK;
    const int qlo = cur.P0 + wid * QBLK, qm = qlo + r32 - 4 * hi;
    char* V_lds = lds; char* K_lds = lds + 2 * SHM_V;
    float* ws = (float*)(lds + 2 * SHM_V + 2 * SHM_K) + wid * 64; float* li_l = ws, * al_l = ws + 32; const float* FT = (const float*)(lds + FT_OFF);
    const float* Fh = cur.F;
    float m_reg = -1e30f, l_reg = 0; f32x16 o[4] = {};
    const int sr = tid >> 4, sc = (tid & 15) * 8, vst0 = v_st(sr, sc), vst1 = v_st(32 + sr, sc), kws = KSWZ(sr, sc * 2);
    const int vb0 = (int)(uintptr_t)V_lds + v_rd_base(lane);
    const TIn* Kh = cur.K; const TIn* Vh = cur.V;
#define RESC(a) do { if (__any((a) < 1.f)) { if (hi == 0) al_l[r32] = (a); asm volatile("s_waitcnt lgkmcnt(0)" ::: "memory");              \
                     for (int d_ = 0; d_ < 4; ++d_) for (int r = 0; r < 16; ++r) o[d_][r] *= al_l[crow(r, hi)]; } } while (0)
#define KBASE(t) ((j_lo + (t)) * KVBLK)
#define ACT(t) (KBASE(t) <= qlo + QBLK - 1 && KBASE(t) + KVBLK - 1 >= qlo - W + 1)
#define MASKT(P0_, P1_, t) do { const int kb_ = KBASE(t); if ((!SK || ACT(t)) && (kb_ + KVBLK - 1 > qlo || kb_ <= qlo + QBLK - 1 - W)) mask_tile(P0_, P1_, qm - kb_, (unsigned)W); } while (0)
    constexpr int NQL = F32 ? 16 : 8;
    constexpr bool SK = WSKIP && !F32;
#define SEAM_K0() do { VMWN(NQL); if constexpr (F32) { SWRITE_KF(0); SBAR(); SLOAD_F((const float*)nxt.V, kbn); } else { SWRITE_HK(0); } SBAR(); } while (0)
    f32x16 pA0, pA1, pB0, pB1; float mnA, mnB, alA, alB; bf16x8 pa0, pa1, pa2, pa3;
    if constexpr (F32) { VMW(); SWRITE_VF(0); SBAR(); } else { SWRITE_HV(0); SBAR(); }
    if (NT > 1) { if constexpr (F32) SLOAD_F((const float*)Kh, KBASE(1)); else SLOAD_H(Kh, Vh, Fh, KBASE(1)); }
    SBAR(); qkt<0, SK>(pA0, pA1, K_lds, r32, hi, S.qr, ACT(0), FT + KBASE(0));
    if constexpr (F32) { if (NT > 1) { VMW(); SWRITE_KF(1); SBAR(); SLOAD_F((const float*)Vh, KBASE(1)); } }
    MASKT(pA0, pA1, 0); partialSM(pA0, pA1, m_reg, mnA, alA);
    if (NT > 1) { VMW(); if constexpr (F32) { SWRITE_VF(1); SBAR(); if (NT > 2) SLOAD_F((const float*)Kh, KBASE(2)); } else SWRITE_H(1); }
    __syncthreads();
#define HALF_STEP(PX0, PX1, mnX, alX, PY0, PY1, alY, t, KB, VB, SB) do {                                                      \
        SBAR(); qkt<KB, SK>(PX0, PX1, K_lds, r32, hi, S.qr, ACT(t), FT + KBASE(t));                                             \
        finishSM(PY0, PY1, alY, l_reg, pa0, pa1, pa2, pa3); SBAR();                                                           \
        if ((t) + 1 < NT) { if constexpr (F32) { VMW(); SWRITE_KF(SB); SBAR(); SLOAD_F((const float*)Vh, KBASE((t) + 1)); }  \
                            else { SLOAD_H(Kh, Vh, Fh, KBASE((t) + 1)); } SBAR(); }                                               \
        pv_tile<VB, SK>(o, vb0, pa0, pa1, pa2, pa3, ACT((t) - 1)); MASKT(PX0, PX1, (t)); partialSM(PX0, PX1, m_reg, mnX, alX);                                        \
        __syncthreads();                                                                                                      \
        if ((t) + 1 < NT) { VMW(); if constexpr (F32) { SWRITE_VF(SB); SBAR(); if ((t) + 2 < NT) SLOAD_F((const float*)Kh, KBASE((t) + 2)); } \
                            else { SWRITE_H(SB); } }                                                                          \
        RESC(alX); __syncthreads(); } while (0)
    for (int t = 1; t + 1 < NT; t += 2) {
        HALF_STEP(pB0, pB1, mnB, alB, pA0, pA1, alA, t, 1, 0, 0);
        HALF_STEP(pA0, pA1, mnA, alA, pB0, pB1, alB, t + 1, 0, 1, 1);
    }
    const bool even = (NT & 1) == 0;
    if (even) { SBAR(); qkt<1, SK>(pB0, pB1, K_lds, r32, hi, S.qr, ACT(NT - 1), FT + KBASE(NT - 1)); SBAR(); }
#define QROW(e) (nxt.Q + (size_t)(wid * QBLK + r32) * LD + ((e) >> 1) * 16 + hi * 8 + ((e) & 1) * 4)
    if constexpr (F32) { SLOAD_F((const float*)nxt.K, kbn); SBAR();
#pragma unroll
        for (int e = 0; e < 8; ++e) S.tq[e] = *(const f32x4*)QROW(e); }
    else { SLOAD_H(nxt.K, nxt.V, nxt.F, kbn); SBAR();
#pragma unroll
        for (int d0 = 0; d0 < 8; ++d0) S.qr[d0] = load8<TIn>(nxt.Q + (size_t)(wid * QBLK + r32) * LD + d0 * 16 + hi * 8); }
    SBAR();
    finishSM(pA0, pA1, alA, l_reg, pa0, pa1, pa2, pa3); SBAR();
    if constexpr (F32) {
#pragma unroll
        for (int e = 8; e < 16; ++e) S.tq[e] = *(const f32x4*)QROW(e); SBAR(); }
#undef QROW
    pv_tile<0, SK>(o, vb0, pa0, pa1, pa2, pa3, ACT(even ? NT - 2 : NT - 1));
    if (even) { MASKT(pB0, pB1, NT - 1); partialSM(pB0, pB1, m_reg, mnB, alB); __syncthreads(); RESC(alB);
        finishSM(pB0, pB1, alB, l_reg, pa0, pa1, pa2, pa3); SBAR(); pv_tile<1, SK>(o, vb0, pa0, pa1, pa2, pa3, ACT(NT - 1)); }
    SBAR(); SEAM_K0();
    if (hi == 0) li_l[r32] = l_reg; asm volatile("s_waitcnt lgkmcnt(0)" ::: "memory");
    float rli[16];
#pragma unroll
    for (int r = 0; r < 16; ++r) rli[r] = __builtin_amdgcn_rcpf(li_l[crow(r, hi)]);
    TOut* Ow = cur.O + (size_t)(wid * QBLK) * LD;
#pragma unroll
    for (int r = 0; r < 16; ++r) { const int orow = crow(r, hi);
#pragma unroll
        for (int d0 = 0; d0 < 4; ++d0) { const float v = o[d0][r] * rli[r];
            if constexpr (same_t<TOut, float>::v) { Ow[(size_t)orow * LD + d0 * 32 + r32] = v; }
            else { const float vn = __shfl_xor(v, 1);
                   if ((r32 & 1) == 0) *(unsigned*)(Ow + (size_t)orow * LD + d0 * 32 + r32) = cvtpk(v, vn); } } }
    if constexpr (F32) {
#pragma unroll
        for (int d0 = 0; d0 < 8; ++d0) S.qr[d0] = pack8(S.tq[2 * d0], S.tq[2 * d0 + 1]); }
    __syncthreads();
#undef RESC
#undef KBASE
#undef ACT
#undef MASKT
#undef SEAM_K0
#undef HALF_STEP
}
#undef ROW
#undef VMW
#undef VMWN
#undef SLOAD_H
#undef SWRITE_HK
#undef SWRITE_HV
#undef SWRITE_H
#undef SLOAD_F
#undef SWRITE_KF
#undef SWRITE_VF
}

#define XB_TMO      128
#define XB_XCNT(j)  (256  + 64 * (j))
#define XB_XSUB(j)  (1280 + 64 * (j))
#define XB_XGEN(j)  (2304 + 64 * (j))
#define XB_TOP      3328
#define XB_TOPGEN   3392
#define XCD_BAR_WORDS 3456
#define XB_SPIN_CAP (1u << 18)

__device__ __forceinline__ unsigned xb_ld(unsigned* p)              { return __hip_atomic_load(p, __ATOMIC_RELAXED, __HIP_MEMORY_SCOPE_AGENT); }
__device__ __forceinline__ unsigned xb_add(unsigned* p, unsigned v) { return __hip_atomic_fetch_add(p, v, __ATOMIC_RELAXED, __HIP_MEMORY_SCOPE_AGENT); }
__device__ __forceinline__ unsigned xb_xcc_id() { return (unsigned)__builtin_amdgcn_s_getreg((3 << 11) | 20) & 0xFu; }
#define XB_SPIN(cond, bar) do { unsigned _sp = 0; while (cond) { __builtin_amdgcn_s_sleep(1); \
    if ((++_sp & 255u) == 0u) { if (xb_ld(&(bar)[XB_TMO])) break; if (_sp > XB_SPIN_CAP) { atomicAdd(&(bar)[XB_TMO], 1u); break; } } } } while (0)

struct XcdBarrier {
    unsigned* bar; unsigned x;
    volatile LAS unsigned* st;
};

__device__ __forceinline__ XcdBarrier xcd_barrier_post(unsigned* bar, volatile LAS unsigned* st) {
    XcdBarrier b; b.bar = bar; b.x = xb_xcc_id(); b.st = st;
    if (threadIdx.x == 0) (void)xb_add(&bar[XB_XCNT(b.x)], 1u);
    return b;
}
__device__ __forceinline__ void xcd_barrier_complete(unsigned* bar, unsigned x, unsigned& nloc, unsigned& nx) {
    const unsigned G = gridDim.x * gridDim.y * gridDim.z;
    unsigned sum, cnt, mine, sp = 0u;
    for (;;) {
        sum = 0u; cnt = 0u; mine = 0u;
#pragma unroll
        for (unsigned j = 0; j < 16; ++j) { const unsigned c = xb_ld(&bar[XB_XCNT(j)]); sum += c; cnt += (c > 0u) ? 1u : 0u; mine = (j == x) ? c : mine; }
        if (sum == G) break;
        __builtin_amdgcn_s_sleep(1);
        if ((++sp & 255u) == 0u) { if (xb_ld(&bar[XB_TMO])) break; if (sp > XB_SPIN_CAP) { atomicAdd(&bar[XB_TMO], 1u); break; } }
    }
    nloc = mine > 0u ? mine : 1u; nx = cnt > 0u ? cnt : 1u;
}

__device__ __forceinline__ void xcd_barrier(const XcdBarrier& b) {
    asm volatile("s_waitcnt vmcnt(0)" ::: "memory");
    __syncthreads();
    if (threadIdx.x == 0) {
        unsigned* bar = b.bar;
        __builtin_amdgcn_s_waitcnt(0);
        unsigned nloc = b.st[0], nx = b.st[1];
        if (nloc == 0u) { xcd_barrier_complete(bar, b.x, nloc, nx); b.st[0] = nloc; b.st[1] = nx; }
        const unsigned old = xb_add(&bar[XB_XSUB(b.x)], 1u);
        const unsigned gen = old / nloc;
        if (old + 1u == (gen + 1u) * nloc) {
            __builtin_amdgcn_fence(__ATOMIC_RELEASE, "agent");
            asm volatile("s_waitcnt vmcnt(0)" ::: "memory");
            const unsigned og = xb_add(&bar[XB_TOP], 1u);
            const unsigned tg = og / nx;
            if (og + 1u == (tg + 1u) * nx) xb_add(&bar[XB_TOPGEN], 1u);
            else XB_SPIN(xb_ld(&bar[XB_TOPGEN]) == tg, bar);
            __builtin_amdgcn_fence(__ATOMIC_ACQUIRE, "agent");
            xb_add(&bar[XB_XGEN(b.x)], 1u);
            asm volatile("s_waitcnt vmcnt(0)" ::: "memory");
        } else {
            XB_SPIN(xb_ld(&bar[XB_XGEN(b.x)]) == gen, bar);
            __builtin_amdgcn_fence(__ATOMIC_ACQUIRE, "agent");
            asm volatile("s_waitcnt vmcnt(0)" ::: "memory");
        }
    }
    __syncthreads();
}

typedef float f32x2_t __attribute__((ext_vector_type(2))); typedef __bf16 bf16x2_t __attribute__((ext_vector_type(2)));
__device__ __forceinline__ unsigned cvtpk_c(float lo, float hi) { f32x2_t v = {lo, hi}; bf16x2_t b = __builtin_convertvector(v, bf16x2_t); return __builtin_bit_cast(unsigned, b); }

#define WSP(T, off) ((T*)(pq->ws + (off)))
__device__ __forceinline__ unsigned short f2bf1(float v) { return (unsigned short)(pk2(v, 0.f) & 0xffffu); }

__device__ __forceinline__ int in_srccol(int n) {
    if (n < 3072) return n;
    if (n < 6144) return n + 8;
    if (n < 8192) return n + 24;
    if (n < 8200) return 3072 + (n - 8192);
    if (n < 8216) return 6152 + (n - 8200);
    return -1;
}
template <bool MAPIN>
__device__ __forceinline__ void transpose_item(const float* __restrict__ W, int K, int Nsrc, int Ndst, bf16_t* __restrict__ WT, LAS float* scr, int item, int lane) {
    const int nblk = Ndst / 32, kb = item / nblk, nb = item % nblk, k0 = 64 * kb, n0 = 32 * nb;
    const int n = n0 + (lane & 31); const int sc = MAPIN ? in_srccol(n) : n;
#pragma unroll 16
    for (int i = 0; i < 32; ++i) { const int kk = 2 * i + (lane >> 5); scr[kk * 33 + (lane & 31)] = sc >= 0 ? W[(size_t)(k0 + kk) * Nsrc + sc] : 0.f; }
    const int c = lane & 7;
#pragma unroll
    for (int j = 0; j < 4; ++j) { const int n_ = (lane >> 3) + 8 * j; const LAS float* s = scr + (8 * c) * 33 + n_;
        u32x4 o; o.x = pk2(s[0 * 33], s[1 * 33]); o.y = pk2(s[2 * 33], s[3 * 33]); o.z = pk2(s[4 * 33], s[5 * 33]); o.w = pk2(s[6 * 33], s[7 * 33]);
        *(u32x4*)(WT + (size_t)(n0 + n_) * K + k0 + 8 * c) = o; }
}
__device__ __forceinline__ void phase0(PP pq, LAS unsigned char* lds, int tid, int lane, int wave) {
    if (blockIdx.x == 0 && tid < 32) WSP(unsigned, WS_NRM)[tid] = 0u;
    {
        LAS float* SC = (LAS float*)lds; LAS float* PR = (LAS float*)(lds + 17 * 1024 * 4);
        const float* cp = pq->in[I_CP]; const float* cs = pq->in[I_CS];
        for (int i = tid; i < 17 * 1024; i += NTHR) { const int r = i >> 10, k = i & 1023; const float c = r == 0 ? cp[k] : cs[(r - 1) * 1024 + k]; SC[i] = siluf_(c); }
        __syncthreads();
        const float* wada = pq->in[I_WADA]; const float* bada = pq->in[I_BADA]; float* mod = WSP(float, WS_MOD);
        for (int cb = blockIdx.x; cb < 256; cb += gridDim.x) {
            const int kq = tid >> 3, cq = tid & 7, col = cb * 24 + cq * 3;
            float acc[17][3];
#pragma unroll
            for (int r = 0; r < 17; ++r) { acc[r][0] = 0.f; acc[r][1] = 0.f; acc[r][2] = 0.f; }
#pragma unroll 4
            for (int kk = 0; kk < 16; ++kk) { const int k = kq + 64 * kk; const float* wr = wada + (size_t)k * 6144 + col; const float w0 = wr[0], w1 = wr[1], w2 = wr[2];
#pragma unroll
                for (int r = 0; r < 17; ++r) { const float s = SC[r * 1024 + k]; acc[r][0] += s * w0; acc[r][1] += s * w1; acc[r][2] += s * w2; } }
#pragma unroll
            for (int r = 0; r < 17; ++r)
#pragma unroll
                for (int j = 0; j < 3; ++j) { float a = acc[r][j]; a += __shfl_xor(a, 8); a += __shfl_xor(a, 16); a += __shfl_xor(a, 32); acc[r][j] = a; }
            if ((lane >> 3) == 0) {
#pragma unroll
                for (int r = 0; r < 17; ++r)
#pragma unroll
                    for (int j = 0; j < 3; ++j) PR[wave * 408 + r * 24 + cq * 3 + j] = acc[r][j];
            }
            __syncthreads();
            if (tid < 408) { const int r = tid / 24, cc = tid % 24; float s = 0.f;
#pragma unroll
                for (int w = 0; w < 8; ++w) s += PR[w * 408 + tid];
                mod[r * 6144 + cb * 24 + cc] = s + bada[cb * 24 + cc]; }
            __syncthreads();
        }
    }
    {
        LAS float* scr = (LAS float*)(lds + wave * 16384);
        const int gw = blockIdx.x * NWV + wave, ngw = gridDim.x * NWV;
        constexpr int I_IN = (DM / 64) * (NIN / 32);
        (void)scr; (void)gw; (void)ngw; (void)I_IN;
        { LAS float* T = (LAS float*)lds; const float* W = pq->in[I_WIN]; bf16_t* WT = WSP(bf16_t, WS_WTIN);
          const int kk = tid >> 5, c8 = (tid & 31) * 8, nn = tid >> 1, kh = (tid & 1) * 8;
          f32x4 pa = (f32x4){0.f, 0.f, 0.f, 0.f}, pb = pa;
          { const int it0 = blockIdx.x; if (it0 < 64 * 33) { const int kb = it0 / 33, nb = it0 - kb * 33; if (nb < 32) { const float* src = W + (size_t)(16 * kb + kk) * 8216 + in_srccol(256 * nb) + c8; pa = *(const f32x4*)src; pb = *(const f32x4*)(src + 4); } } }
          for (int it = blockIdx.x; it < 64 * 33; it += gridDim.x) { const int kb = it / 33, nb = it - kb * 33, k0 = 16 * kb, n0 = 256 * nb;
              __syncthreads();
              if (nb < 32) { *(LAS f32x4*)(T + kk * 260 + c8) = pa; *(LAS f32x4*)(T + kk * 260 + c8 + 4) = pb;
                  }
              else {
#pragma unroll
                  for (int e = 0; e < 8; ++e) { const int sc = in_srccol(n0 + c8 + e); T[kk * 260 + c8 + e] = sc >= 0 ? W[(size_t)(k0 + kk) * 8216 + sc] : 0.f; } }
              { const int itn = it + gridDim.x; if (itn < 64 * 33) { const int kbn = itn / 33, nbn = itn - kbn * 33; if (nbn < 32) { const float* src = W + (size_t)(16 * kbn + kk) * 8216 + in_srccol(256 * nbn) + c8; pa = *(const f32x4*)src; pb = *(const f32x4*)(src + 4); } } }
              __syncthreads();
              u32x4 o; o.x = pk2(T[(kh + 0) * 260 + nn], T[(kh + 1) * 260 + nn]); o.y = pk2(T[(kh + 2) * 260 + nn], T[(kh + 3) * 260 + nn]);
              o.z = pk2(T[(kh + 4) * 260 + nn], T[(kh + 5) * 260 + nn]); o.w = pk2(T[(kh + 6) * 260 + nn], T[(kh + 7) * 260 + nn]);
              *(u32x4*)(WT + (size_t)(n0 + nn) * DM + k0 + kh) = o; }
          __syncthreads(); }
    }
}
__device__ __forceinline__ void block_transpose(const float* __restrict__ W, int K, int N, bf16_t* __restrict__ WT, LAS unsigned char* lds, int tid, int first, int nw) {
    LAS float* T = (LAS float*)lds; const int nnb = N / 256, nitems = (K / 16) * nnb;
    const int kk = tid >> 5, c8 = (tid & 31) * 8, nn = tid >> 1, kh = (tid & 1) * 8;
    for (int it = first; it < nitems; it += nw) { const int kb = it / nnb, nb = it - kb * nnb, k0 = 16 * kb, n0 = 256 * nb;
        __syncthreads();
        { const float* src = W + (size_t)(k0 + kk) * N + n0 + c8; const f32x4 a = *(const f32x4*)src, b = *(const f32x4*)(src + 4); *(LAS f32x4*)(T + kk * 260 + c8) = a; *(LAS f32x4*)(T + kk * 260 + c8 + 4) = b; }
        __syncthreads();
        u32x4 o; o.x = pk2(T[(kh + 0) * 260 + nn], T[(kh + 1) * 260 + nn]); o.y = pk2(T[(kh + 2) * 260 + nn], T[(kh + 3) * 260 + nn]);
        o.z = pk2(T[(kh + 4) * 260 + nn], T[(kh + 5) * 260 + nn]); o.w = pk2(T[(kh + 6) * 260 + nn], T[(kh + 7) * 260 + nn]);
        *(u32x4*)(WT + (size_t)(n0 + nn) * K + k0 + kh) = o; }
    __syncthreads();
}
__device__ __forceinline__ void late_transposes(PP pq, LAS unsigned char* lds, int tid, int first, int nw) {
    block_transpose(pq->in[I_WOUT], DM, DM, WSP(bf16_t, WS_WTOUT), lds, tid, first, nw);
    block_transpose(pq->in[I_WUP], DM, DFF, WSP(bf16_t, WS_WTUP), lds, tid, first, nw);
    block_transpose(pq->in[I_WDN], DFF, DM, WSP(bf16_t, WS_WTDN), lds, tid, first, nw);
}

__device__ __forceinline__ const float* xrow_ptr(PP pq, int row) { return row < SEQ ? pq->in[I_XP] + (size_t)row * DM : pq->in[I_XS] + (size_t)(row - SEQ) * DM; }
__device__ __forceinline__ float* yrow_ptr(PP pq, int row) { return row < SEQ ? pq->out + O_YP + (size_t)row * DM : pq->out + O_YS + (size_t)(row - SEQ) * DM; }
__device__ __forceinline__ int modrow(int row) { return row < SEQ ? 0 : 1 + ((row - SEQ) >> 4); }
__device__ __forceinline__ float sumsq4(const f32x4 (&v)[4]) { float s = 0.f;
#pragma unroll
    for (int j = 0; j < 4; ++j) s += (v[j].x * v[j].x + v[j].y * v[j].y) + (v[j].z * v[j].z + v[j].w * v[j].w);
    return s; }
__device__ __forceinline__ void modnorm_store(const f32x4 (&v)[4], float rstd, const float* g, const float* sc, const float* sh, bf16_t* orow, int lane) {
#pragma unroll
    for (int j = 0; j < 4; ++j) { const int c = 4 * lane + 256 * j; const f32x4 gg = *(const f32x4*)(g + c), s1 = *(const f32x4*)(sc + c), s0 = *(const f32x4*)(sh + c);
        const f32x4 o = v[j] * rstd * gg * (s1 + 1.f) + s0; u32x2 w; w.x = pk2(o.x, o.y); w.y = pk2(o.z, o.w); *(u32x2*)(orow + c) = w; }
}
__device__ __forceinline__ void phase1(PP pq, int lane, int gw, int ngw) {
    const float* mod = WSP(float, WS_MOD); bf16_t* H = WSP(bf16_t, WS_H);
    for (int row = gw; row < R; row += 2 * ngw) {
        const int r1 = row + ngw; const bool has1 = r1 < R; const int rb = has1 ? r1 : row;
        const f32x4* xa = (const f32x4*)xrow_ptr(pq, row) + lane; const f32x4* xb = (const f32x4*)xrow_ptr(pq, rb) + lane; f32x4 va[4], vb[4];
#pragma unroll
        for (int j = 0; j < 4; ++j) { va[j] = xa[64 * j]; vb[j] = xb[64 * j]; }
        const float ra = 1.f / sqrtf(wave_sum(sumsq4(va)) * (1.f / DM) + EPS), rbs = 1.f / sqrtf(wave_sum(sumsq4(vb)) * (1.f / DM) + EPS);
        const float* ma = mod + (size_t)modrow(row) * 6144; const float* mb = mod + (size_t)modrow(rb) * 6144;
        modnorm_store(va, ra, pq->in[I_GPM], ma + 1024, ma, H + (size_t)row * DM, lane);
        if (has1) modnorm_store(vb, rbs, pq->in[I_GPM], mb + 1024, mb, H + (size_t)rb * DM, lane);
    }
}

__device__ __forceinline__ void unpack16(const bf16_t* ptr, float (&f)[16]) {
    const u32x4 a = *(const u32x4*)ptr, b = *(const u32x4*)(ptr + 8);
    f[0] = bflo(a.x); f[1] = bfhi(a.x); f[2] = bflo(a.y); f[3] = bfhi(a.y); f[4] = bflo(a.z); f[5] = bfhi(a.z); f[6] = bflo(a.w); f[7] = bfhi(a.w);
    f[8] = bflo(b.x); f[9] = bfhi(b.x); f[10] = bflo(b.y); f[11] = bfhi(b.y); f[12] = bflo(b.z); f[13] = bfhi(b.z); f[14] = bflo(b.w); f[15] = bfhi(b.w);
}
__device__ __forceinline__ float block_excl_scan(float v, LAS float* sm, int lane, int wave) {
    float inc = v;
#pragma unroll
    for (int o = 1; o < 64; o <<= 1) { const float t = __shfl_up(inc, o); if (lane >= o) inc += t; }
    __syncthreads();
    if (lane == 63) sm[wave] = inc;
    __syncthreads();
    float base = 0.f;
    for (int w = 0; w < wave; ++w) base += sm[w];
    return base + inc - v;
}
__device__ __forceinline__ void phase3(PP pq, LAS unsigned char* lds, int tid, int lane, int wave) {
    {
        const bf16_t* Qb = WSP(bf16_t, WS_Q); const bf16_t* Kb = WSP(bf16_t, WS_K); float mq = 0.f, mk = 0.f;
        for (int row0 = blockIdx.x * NWV + wave; row0 < SEQ; row0 += 2 * gridDim.x * NWV) {
            const int row1 = row0 + gridDim.x * NWV; const bool has1 = row1 < SEQ; const int rr[2] = {row0, has1 ? row1 : row0};
            float a[2][16], b[2][16];
#pragma unroll
            for (int t = 0; t < 2; ++t) { unpack16(Qb + (size_t)rr[t] * DM + 16 * lane, a[t]); unpack16(Kb + (size_t)rr[t] * DM + 16 * lane, b[t]); }
#pragma unroll
            for (int t = 0; t < 2; ++t) { float sa = 0.f, sb = 0.f, sd = 0.f;
#pragma unroll
                for (int e = 0; e < 16; ++e) { sa += a[t][e] * a[t][e]; sb += b[t][e] * b[t][e]; sd += a[t][e] * b[t][e]; }
                sa += __shfl_xor(sa, 1); sa += __shfl_xor(sa, 2); sa += __shfl_xor(sa, 4); sb += __shfl_xor(sb, 1); sb += __shfl_xor(sb, 2); sb += __shfl_xor(sb, 4);
                sd += __shfl_xor(sd, 1); sd += __shfl_xor(sd, 2); sd += __shfl_xor(sd, 4);
                if ((lane & 7) == 0 && (t == 0 || has1)) { WSP(float, WS_GQ)[(size_t)(lane >> 3) * SEQ + rr[t]] = sqrtf(sa); WSP(float, WS_GD)[(size_t)(lane >> 3) * SEQ + rr[t]] = sd * FOX_SCALE; }
                mq = fmaxf(mq, sa); mk = fmaxf(mk, sb); } }
        LAS float* red = (LAS float*)(lds + 4096);
        if ((lane & 7) == 0) { red[wave * 16 + (lane >> 3)] = mq; red[wave * 16 + 8 + (lane >> 3)] = mk; }
        __syncthreads();
        if (tid < 16) { float m = red[tid];
#pragma unroll
            for (int w = 1; w < 8; ++w) m = fmaxf(m, red[w * 16 + tid]);
            atomicMax(WSP(unsigned, WS_NRM) + tid, __float_as_uint(m)); }
        __syncthreads();
    }
    LAS float* sm = (LAS float*)lds; const float* LOGF = WSP(float, WS_LOGF);
    for (int u = blockIdx.x; u < 8 + 128; u += gridDim.x) {
        if (u < 8) { const int h = u, base = tid * 32; float loc = 0.f; const f32x4* lt4 = (const f32x4*)(WSP(float, WS_LOGFT) + (size_t)h * SEQ + base); f32x4 lv[8];
#pragma unroll
            for (int j = 0; j < 8; ++j) { lv[j] = lt4[j]; loc += (lv[j].x + lv[j].y) + (lv[j].z + lv[j].w); }
            float run = block_excl_scan(loc, sm, lane, wave); f32x4* FSP4 = (f32x4*)(WSP(float, WS_FSP) + (size_t)h * SEQ + base);
#pragma unroll
            for (int j = 0; j < 8; ++j) { f32x4 o; run += lv[j].x; o.x = run * INV_SCALE; run += lv[j].y; o.y = run * INV_SCALE; run += lv[j].z; o.z = run * INV_SCALE; run += lv[j].w; o.w = run * INV_SCALE; FSP4[j] = o; }
        } else { const int bh = u - 8, b = bh >> 3, h = bh & 7, base = tid * 3; float vals[3]; float loc = 0.f;
#pragma unroll
            for (int j = 0; j < 3; ++j) { const int s = base + j; float v = 0.f;
                if (s < TKS) v = s < PAST ? pq->in[I_CLF][((size_t)b * PAST + s) * 8 + h] : LOGF[(size_t)(SEQ + b * 16 + s - PAST) * 8 + h];
                vals[j] = v; loc += v; }
            float run = block_excl_scan(loc, sm, lane, wave); float* FSS = WSP(float, WS_FSS) + (size_t)bh * TKS;
#pragma unroll
            for (int j = 0; j < 3; ++j) { run += vals[j]; if (base + j < TKS) FSS[base + j] = run; }
        }
    }
}

typedef att::BlockRef<att::bf16, att::bf16> ABlk;
__device__ __forceinline__ ABlk attn_ref(PP pq, int idx) {
    const int L = blockIdx.x + (idx >> 1) * gridDim.x, head = L >> 5, x = L & 31, qb = (idx & 1) ? 63 - x : x, P0 = qb * 256;
    ABlk r; r.Q = WSP(att::bf16, WS_Q) + (size_t)P0 * DM + head * HD; r.K = WSP(att::bf16, WS_K) + head * HD; r.V = WSP(att::bf16, WS_V) + head * HD;
    r.O = WSP(att::bf16, WS_H) + (size_t)P0 * DM + head * HD; r.F = WSP(float, WS_FSP) + (size_t)head * SEQ; r.P0 = P0;
    { const unsigned* nrm = WSP(unsigned, WS_NRM); const float U = sqrtf(__uint_as_float(nrm[head]) * __uint_as_float(nrm[8 + head])) * FOX_SCALE;
      int ln = threadIdx.x & 63; asm volatile("" : "+v"(ln));
      const float kmaxs = sqrtf(__uint_as_float(nrm[8 + head])) * FOX_SCALE; const float* gq = WSP(float, WS_GQ) + (size_t)head * SEQ + P0; const float* gd = WSP(float, WS_GD) + (size_t)head * SEQ + P0;
      float gmin = fminf(fminf(gd[ln] - gq[ln] * kmaxs, gd[ln + 64] - gq[ln + 64] * kmaxs), fminf(gd[ln + 128] - gq[ln + 128] * kmaxs, gd[ln + 192] - gq[ln + 192] * kmaxs));
#pragma unroll
      for (int o = 1; o < 64; o <<= 1) gmin = fminf(gmin, __shfl_xor(gmin, o));
      const float thrS = (fmaxf(gmin, -2.f * U) - 32.f) * INV_SCALE, f0 = r.F[P0]; const int jd = P0 >> 6; int best = jd;
#pragma unroll
      for (int k = 0; k < 4; ++k) { const int j = ln + 64 * k; const bool ok = (j <= jd) && (f0 - r.F[64 * (j <= jd ? j : jd) + 63] >= thrS);
          const unsigned long long m = __ballot(ok); if (m) { const int first = __builtin_ctzll(m) + 64 * k; best = first < best ? first : best; } }
      r.jlo = __builtin_amdgcn_readfirstlane(best); }
    return r;
}
__device__ __forceinline__ void phase4(PP pq, char* lds) {
    if ((int)blockIdx.x >= 256) return;
    const int nmine = (256 - (int)blockIdx.x + (int)gridDim.x - 1) / (int)gridDim.x, nb = 2 * nmine;
    constexpr int W = 1 << 30;
    att::Seam<att::bf16> S;
    ABlk cur = attn_ref(pq, 0);
    att::causal_swa_prime<att::bf16, att::bf16>(cur, W, lds, S);
    float* FT = (float*)(lds + att::FT_OFF);
    for (int idx = 0; idx < nb; ++idx) {
        const ABlk nxt = (idx + 1 < nb) ? attn_ref(pq, idx + 1) : cur;
        { const float fref = cur.F[cur.P0];
            int t4_ = threadIdx.x * 4; asm volatile("" : "+v"(t4_));
            for (int s0 = cur.jlo * 64 + t4_; s0 < cur.P0 + 256; s0 += NTHR * 4) { const f32x4 f = *(const f32x4*)(cur.F + s0); *(f32x4*)(FT + s0) = (f32x4){fref - f.x, fref - f.y, fref - f.z, fref - f.w}; }
            __syncthreads(); }
        att::causal_swa_block<att::bf16, att::bf16>(cur, nxt, SEQ, W, lds, S);
        cur = nxt;
    }
}

__device__ __forceinline__ void sample_attn(PP pq, LAS unsigned char* lds, int tid, int b, int h) {
    LAS float* S = (LAS float*)lds; LAS float* Ql = S + 16 * TKS; LAS float* Fl = Ql + 16 * 128; LAS float* inv = Fl + TKS;
    bf16_t* Qb = WSP(bf16_t, WS_Q); const bf16_t* Kb = WSP(bf16_t, WS_K); const bf16_t* Vb = WSP(bf16_t, WS_V);
    const float* FSS = WSP(float, WS_FSS) + (size_t)(b * 8 + h) * TKS;
    __syncthreads();
#pragma unroll 1
    for (int idx = tid; idx < 2048; idx += NTHR) { const int i = idx >> 7, d = idx & 127; Ql[idx] = bf2f(Qb[(size_t)(SEQ + b * 16 + i) * DM + h * HD + d]); }
#pragma unroll 1
    for (int idx = tid; idx < TKS; idx += NTHR) Fl[idx] = FSS[idx];
    __syncthreads();
    {
        const int lane_ = tid & 63, wave_ = tid >> 6, fr = lane_ & 15, fq = lane_ >> 4;
        bf16x8 qf[4];
#pragma unroll
        for (int ks = 0; ks < 4; ++ks) qf[ks] = *(const bf16x8*)(Qb + (size_t)(SEQ + b * 16 + fr) * DM + h * HD + 32 * ks + 8 * fq);
#pragma unroll 3
        for (int kt = wave_; kt < 65; kt += 8) {
            bf16x8 kf[4];
            if (kt < 64) { const float* kr = pq->in[I_CK] + ((size_t)(b * PAST + kt * 16 + fr) * NH + h) * HD + 8 * fq;
#pragma unroll
                for (int ks = 0; ks < 4; ++ks) { const f32x4 a = *(const f32x4*)(kr + 32 * ks), c = *(const f32x4*)(kr + 32 * ks + 4);
                    const u32x4 w = (u32x4){cvtpk_c(a.x, a.y), cvtpk_c(a.z, a.w), cvtpk_c(c.x, c.y), cvtpk_c(c.z, c.w)}; kf[ks] = __builtin_bit_cast(bf16x8, w); } }
            else { const bf16_t* kr = Kb + (size_t)(SEQ + b * 16 + fr) * DM + h * HD + 8 * fq;
#pragma unroll
                for (int ks = 0; ks < 4; ++ks) kf[ks] = *(const bf16x8*)(kr + 32 * ks); }
            f32x4 acc = (f32x4){0.f, 0.f, 0.f, 0.f};
#pragma unroll
            for (int ks = 0; ks < 4; ++ks) acc = __builtin_amdgcn_mfma_f32_16x16x32_bf16(qf[ks], kf[ks], acc, 0, 0, 0);
            const int s = kt * 16 + fr; const float fs = Fl[s];
#pragma unroll
            for (int j = 0; j < 4; ++j) { const int i = 4 * fq + j; float v = acc[j] * FOX_SCALE + Fl[PAST + i] - fs; if (s > PAST + i) v = -__builtin_inff(); S[i * TKS + s] = v; }
        }
    }
    __syncthreads();
    { const int i = tid >> 5, l32 = tid & 31; float mx = -__builtin_inff();
#pragma unroll 1
        for (int s = l32; s < TKS; s += 32) mx = fmaxf(mx, S[i * TKS + s]);
#pragma unroll
        for (int o = 1; o < 32; o <<= 1) mx = fmaxf(mx, __shfl_xor(mx, o));
        float sum = 0.f;
#pragma unroll 1
        for (int s = l32; s < TKS; s += 32) { const float e = __expf(S[i * TKS + s] - mx); S[i * TKS + s] = e; sum += e; }
#pragma unroll
        for (int o = 1; o < 32; o <<= 1) sum += __shfl_xor(sum, o);
        if (l32 == 0) inv[i] = 1.f / sum; }
    __syncthreads();
    {
        const int d4 = (tid & 31) * 4, kg = tid >> 5; f32x4 o[16];
#pragma unroll
        for (int i = 0; i < 16; ++i) o[i] = (f32x4){0.f, 0.f, 0.f, 0.f};
        const float* vr = pq->in[I_CV] + ((size_t)(b * PAST) * NH + h) * HD + d4;
#pragma unroll 5
        for (int k = 0; k < 65; ++k) { const int sidx = kg * 65 + k; f32x4 v;
            if (sidx < PAST) v = *(const f32x4*)(vr + (size_t)sidx * NH * HD);
            else { const u32x2 vw = *(const u32x2*)(Vb + (size_t)(SEQ + b * 16 + sidx - PAST) * DM + h * HD + d4); v = (f32x4){bflo(vw.x), bfhi(vw.x), bflo(vw.y), bfhi(vw.y)}; }
#pragma unroll
            for (int i = 0; i < 16; ++i) o[i] += v * S[i * TKS + sidx]; }
#pragma unroll
        for (int i = 0; i < 16; ++i) { o[i].x += __shfl_xor(o[i].x, 32); o[i].y += __shfl_xor(o[i].y, 32); o[i].z += __shfl_xor(o[i].z, 32); o[i].w += __shfl_xor(o[i].w, 32); }
        __syncthreads();
        if ((tid & 32) == 0) {
#pragma unroll
            for (int i = 0; i < 16; ++i) *(LAS f32x4*)(S + ((tid >> 6) * 16 + i) * 128 + d4) = o[i]; }
        __syncthreads();
        for (int idx = tid; idx < 2048; idx += NTHR) { const int i = idx >> 7, d = idx & 127; float a = 0.f;
#pragma unroll
            for (int w8 = 0; w8 < 8; ++w8) a += S[(w8 * 16 + i) * 128 + d];
            WSP(bf16_t, WS_H)[(size_t)(SEQ + b * 16 + i) * DM + h * HD + d] = f2bf1(a * inv[i]); }
    }
}

__device__ __forceinline__ void ssd_seq(PP pq, LAS unsigned char* lds, int tid, int row0, int L, int TB, int head, const float* init, float* outst, const float* convinit) {
    const bf16_t* XBC = WSP(bf16_t, WS_XBC); bf16_t* Z = WSP(bf16_t, WS_Z); const float* DT = WSP(float, WS_DT);
    LAS float* xs = (LAS float*)lds; LAS float* Bc = xs + 64 * 64; LAS float* Cc = Bc + 64 * 128; LAS float* zl = Cc + 64 * 128; LAS float* yl = zl + 64 * 64; LAS float* dtl = yl + 64 * 64;
    const int g = head >> 2, pp = tid >> 3, ns = tid & 7, n0 = ns * 16;
    const float A = -__expf(pq->in[I_ALOG][head]), Dh = pq->in[I_DSKIP][head];
    const float* cw = pq->in[I_CW]; const float* cbias = pq->in[I_CB];
    float s[16];
#pragma unroll
    for (int j = 0; j < 16; ++j) s[j] = init ? init[(size_t)(head * SP + pp) * SN + n0 + j] : 0.f;
    for (int t0 = 0; t0 < L; t0 += TB) {
        __syncthreads();
#pragma unroll 1
        for (int idx = tid; idx < TB * 320; idx += NTHR) { const int tt = idx / 320, cc = idx - tt * 320;
            const int ch = cc < 64 ? head * 64 + cc : (cc < 192 ? 1024 + g * 128 + (cc - 64) : 1536 + g * 128 + (cc - 192));
            float a = cbias[ch];
#pragma unroll
            for (int i = 0; i < 4; ++i) { const int tr = t0 + tt - 3 + i; float xv;
                if (tr >= 0) xv = bf2f(XBC[(size_t)(row0 + tr) * CONVD + ch]); else xv = convinit ? convinit[(3 + tr) * CONVD + ch] : 0.f;
                a += cw[i * CONVD + ch] * xv; }
            a = siluf_(a);
            if (cc < 64) xs[tt * 64 + cc] = a; else if (cc < 192) Bc[tt * 128 + cc - 64] = a; else Cc[tt * 128 + cc - 192] = a; }
#pragma unroll 1
        for (int idx = tid; idx < TB * 64; idx += NTHR) { const int tt = idx >> 6, c = idx & 63; zl[idx] = bf2f(Z[(size_t)(row0 + t0 + tt) * DM + head * 64 + c]); }
        if (tid < TB) dtl[tid] = DT[(size_t)(row0 + t0 + tid) * 16 + head];
        __syncthreads();
#pragma unroll 2
        for (int tt = 0; tt < TB; ++tt) {
            const float dtv = dtl[tt], dA = __expf(dtv * A), x = xs[tt * 64 + pp], xdt = x * dtv; float y = 0.f;
#pragma unroll
            for (int j4 = 0; j4 < 4; ++j4) { const f32x4 bv = *(const LAS f32x4*)(Bc + tt * 128 + n0 + 4 * j4), cv = *(const LAS f32x4*)(Cc + tt * 128 + n0 + 4 * j4);
#pragma unroll
                for (int j = 0; j < 4; ++j) { s[4 * j4 + j] = s[4 * j4 + j] * dA + xdt * bv[j]; y += cv[j] * s[4 * j4 + j]; } }
            y += __shfl_xor(y, 1); y += __shfl_xor(y, 2); y += __shfl_xor(y, 4);
            if (ns == 0) yl[tt * 64 + pp] = (y + Dh * x) * siluf_(zl[tt * 64 + pp]);
        }
        __syncthreads();
#pragma unroll 1
        for (int idx = tid; idx < TB * 64; idx += NTHR) { const int tt = idx >> 6, c = idx & 63; WSP(bf16_t, WS_YS)[(size_t)(row0 + t0 + tt) * DM + head * 64 + c] = f2bf1(yl[idx]); }
    }
#pragma unroll
    for (int j4 = 0; j4 < 4; ++j4) *(f32x4*)(outst + (size_t)(head * SP + pp) * SN + n0 + 4 * j4) = (f32x4){s[4 * j4], s[4 * j4 + 1], s[4 * j4 + 2], s[4 * j4 + 3]};
}
constexpr int SD_CN = 0, SD_BN = 17408, SD_BT = 34816, SD_XT = 53248, SD_ACS = 90112, SD_DTL = 91136, SD_WL = 92160;
constexpr int CNS = 136, XTS = 72;
typedef float f32x16 __attribute__((ext_vector_type(16)));
#define MFMA32(a, b, c) __builtin_amdgcn_mfma_f32_32x32x16_bf16((a), (b), (c), 0, 0, 0)
__device__ __forceinline__ void ssd_stage(PP pq, LAS unsigned char* lds, int tid, int lane, int wave, int row0, int ntok, int g, const float* convinit, const int mode) {
    const bf16_t* XBC = WSP(bf16_t, WS_XBC);
    const int cb = tid & 63, tg = tid >> 6;
    const int ch = cb < 32 ? g * 256 + 8 * cb : (cb < 48 ? 1024 + g * 128 + 8 * (cb - 32) : 1536 + g * 128 + 8 * (cb - 48));
    const float* cw = pq->in[I_CW]; const float* cbs = pq->in[I_CB];
    if (tg * 8 < ntok && (mode == 1 || cb < 48)) {
    float w[4][8], y[8][8];
#pragma unroll
    for (int i = 0; i < 4; ++i) { const f32x4 a = *(const f32x4*)(cw + i * CONVD + ch), b = *(const f32x4*)(cw + i * CONVD + ch + 4);
        w[i][0] = a.x; w[i][1] = a.y; w[i][2] = a.z; w[i][3] = a.w; w[i][4] = b.x; w[i][5] = b.y; w[i][6] = b.z; w[i][7] = b.w; }
    { const f32x4 a = *(const f32x4*)(cbs + ch), b = *(const f32x4*)(cbs + ch + 4);
#pragma unroll
        for (int t = 0; t < 8; ++t) { y[t][0] = a.x; y[t][1] = a.y; y[t][2] = a.z; y[t][3] = a.w; y[t][4] = b.x; y[t][5] = b.y; y[t][6] = b.z; y[t][7] = b.w; } }
#pragma unroll
    for (int k = 0; k < 11; ++k) { const int rel = 8 * tg - 3 + k; u32x4 v = (u32x4){0u, 0u, 0u, 0u};
        float x[8];
        if (rel < 0 && convinit) { const f32x4 a = *(const f32x4*)(convinit + (size_t)(3 + rel) * CONVD + ch), b = *(const f32x4*)(convinit + (size_t)(3 + rel) * CONVD + ch + 4);
            x[0] = a.x; x[1] = a.y; x[2] = a.z; x[3] = a.w; x[4] = b.x; x[5] = b.y; x[6] = b.z; x[7] = b.w; }
        else { if (row0 + rel >= 0) v = *(const u32x4*)(XBC + (size_t)(row0 + rel) * CONVD + ch);
            x[0] = bflo(v.x); x[1] = bfhi(v.x); x[2] = bflo(v.y); x[3] = bfhi(v.y); x[4] = bflo(v.z); x[5] = bfhi(v.z); x[6] = bflo(v.w); x[7] = bfhi(v.w); }
#pragma unroll
        for (int i = 0; i < 4; ++i) { const int t = k - i;
            if (t >= 0 && t < 8) {
#pragma unroll
                for (int e = 0; e < 8; ++e) y[t][e] += w[i][e] * x[e]; } } }
#pragma unroll
    for (int t = 0; t < 8; ++t)
#pragma unroll
        for (int e = 0; e < 8; ++e) y[t][e] = siluf_(y[t][e]);
    LAS bf16_t* CN = (LAS bf16_t*)(lds + SD_CN); LAS bf16_t* BN = (LAS bf16_t*)(lds + SD_BN); LAS bf16_t* BT = (LAS bf16_t*)(lds + SD_BT); LAS bf16_t* XT = (LAS bf16_t*)(lds + SD_XT);
    if (cb < 32) { const int r = cb >> 3, p0 = (cb & 7) * 8;
#pragma unroll
        for (int e = 0; e < 8; ++e) *(LAS u32x4*)(XT + (r * 64 + p0 + e) * XTS + 8 * tg) = (u32x4){cvtpk_c(y[0][e], y[1][e]), cvtpk_c(y[2][e], y[3][e]), cvtpk_c(y[4][e], y[5][e]), cvtpk_c(y[6][e], y[7][e])};
    } else if (cb < 48) { const int n0 = (cb - 32) * 8;
        if (mode == 1) {
#pragma unroll
        for (int t = 0; t < 8; ++t) *(LAS u32x4*)(BN + (8 * tg + t) * CNS + n0) = (u32x4){cvtpk_c(y[t][0], y[t][1]), cvtpk_c(y[t][2], y[t][3]), cvtpk_c(y[t][4], y[t][5]), cvtpk_c(y[t][6], y[t][7])};
        } else {
#pragma unroll
        for (int e = 0; e < 8; ++e) *(LAS u32x4*)(BT + (n0 + e) * XTS + 8 * tg) = (u32x4){cvtpk_c(y[0][e], y[1][e]), cvtpk_c(y[2][e], y[3][e]), cvtpk_c(y[4][e], y[5][e]), cvtpk_c(y[6][e], y[7][e])};
        }
    } else { const int n0 = (cb - 48) * 8;
#pragma unroll
        for (int t = 0; t < 8; ++t) *(LAS u32x4*)(CN + (8 * tg + t) * CNS + n0) = (u32x4){cvtpk_c(y[t][0], y[t][1]), cvtpk_c(y[t][2], y[t][3]), cvtpk_c(y[t][4], y[t][5]), cvtpk_c(y[t][6], y[t][7])};
    }
    }
    if (wave < 4) { const int hd = 4 * g + wave; const float A = -__expf(pq->in[I_ALOG][hd]);
        const float dtv = lane < ntok ? WSP(float, WS_DT)[(size_t)(row0 + lane) * 16 + hd] : 0.f; float acs = dtv * A;
#pragma unroll
        for (int o = 1; o < 64; o <<= 1) { const float t = __shfl_up(acs, o); if (lane >= o) acs += t; }
        const float tot = __shfl(acs, 63);
        LAS float* ACS = (LAS float*)(lds + SD_ACS); LAS float* DTL = (LAS float*)(lds + SD_DTL); LAS float* WL = (LAS float*)(lds + SD_WL);
        ACS[wave * 64 + lane] = acs; DTL[wave * 64 + lane] = dtv; WL[wave * 64 + lane] = dtv * __expf(tot - acs); }
}
__device__ __forceinline__ void unpack8(const u32x4 a, float (&f)[8]) { f[0] = bflo(a.x); f[1] = bfhi(a.x); f[2] = bflo(a.y); f[3] = bfhi(a.y); f[4] = bflo(a.z); f[5] = bfhi(a.z); f[6] = bflo(a.w); f[7] = bfhi(a.w); }
template <int NV, int RL>
__device__ __forceinline__ void merge_thread(PP pq, int row, int col, const LAS float* yl) {
    const bool smp = row >= SEQ; const size_t ro = (size_t)row * DM + col; const size_t so = (size_t)(row - SEQ) * DM + col;
    const bf16_t* Zp = WSP(bf16_t, WS_Z) + ro; bf16_t* Hp = WSP(bf16_t, WS_H) + ro;
    const bf16_t* gap = smp ? WSP(bf16_t, WS_GAS) + so : (const bf16_t*)(pq->out + O_YP) + ro;
    const bf16_t* gbp = smp ? WSP(bf16_t, WS_GBS) + so : (const bf16_t*)(pq->out + O_YP) + (size_t)SEQ * DM + ro;
    const float* sng = pq->in[I_SNG] + col;
    float y[NV][8]; float ss = 0.f;
#pragma unroll
    for (int v = 0; v < NV; ++v) { float z[8]; unpack8(__builtin_nontemporal_load((const u32x4*)(Zp + 8 * v)), z); const f32x4 y0 = *(const LAS f32x4*)(yl + 8 * v), y1 = *(const LAS f32x4*)(yl + 8 * v + 4);
#pragma unroll
        for (int e = 0; e < 8; ++e) { const float yy = (e < 4 ? y0[e & 3] : y1[e & 3]) * siluf_(z[e]); y[v][e] = yy; ss += yy * yy; } }
#pragma unroll
    for (int o = 1; o < RL; o <<= 1) ss += __shfl_xor(ss, o);
    const float rstd = 1.f / sqrtf(ss * (1.f / 256.f) + EPS);
#pragma unroll
    for (int v = 0; v < NV; ++v) { float ya[8], ga[8], gb[8]; unpack8(*(const u32x4*)(Hp + 8 * v), ya); unpack8(__builtin_nontemporal_load((const u32x4*)(gap + 8 * v)), ga); unpack8(__builtin_nontemporal_load((const u32x4*)(gbp + 8 * v)), gb);
        const f32x4 g0 = *(const f32x4*)(sng + 8 * v), g1 = *(const f32x4*)(sng + 8 * v + 4); float m[8];
#pragma unroll
        for (int e = 0; e < 8; ++e) m[e] = sigmoidf_(ga[e]) * ya[e] + sigmoidf_(gb[e]) * (y[v][e] * rstd * (e < 4 ? g0[e & 3] : g1[e & 3]));
        *(u32x4*)(Hp + 8 * v) = (u32x4){pk2(m[0], m[1]), pk2(m[2], m[3]), pk2(m[4], m[5]), pk2(m[6], m[7])}; }
}
constexpr int YLS = 260;
constexpr size_t ST_CH = (size_t)SH * SP * SN;
__device__ __forceinline__ void ssd_passA(PP pq, LAS unsigned char* lds, int tid, int lane, int wave) {
    LAS bf16_t* BT = (LAS bf16_t*)(lds + SD_BT); LAS bf16_t* XT = (LAS bf16_t*)(lds + SD_XT); LAS float* WL = (LAS float*)(lds + SD_WL); LAS float* ACS = (LAS float*)(lds + SD_ACS);
    for (int u = blockIdx.x; u < 1024; u += gridDim.x) { const int c = u >> 2, g = u & 3;
        __syncthreads(); ssd_stage(pq, lds, tid, lane, wave, 64 * c, 64, g, nullptr, 0); __syncthreads();
        const int r = wave >> 1, nh = wave & 1, hd = 4 * g + r, cl = lane & 31, hi = lane >> 5;
        f32x16 acc[2][2];
#pragma unroll
        for (int a = 0; a < 2; ++a)
#pragma unroll
            for (int b = 0; b < 2; ++b)
#pragma unroll
                for (int i = 0; i < 16; ++i) acc[a][b][i] = 0.f;
#pragma unroll
        for (int ks = 0; ks < 4; ++ks) {
            const f32x4 w0 = *(const LAS f32x4*)(WL + r * 64 + 16 * ks + 8 * hi), w1 = *(const LAS f32x4*)(WL + r * 64 + 16 * ks + 8 * hi + 4);
            bf16x8 Bf[2];
#pragma unroll
            for (int pt = 0; pt < 2; ++pt) { const u32x4 raw = *(const LAS u32x4*)(XT + (r * 64 + 32 * pt + cl) * XTS + 16 * ks + 8 * hi);
                u32x4 sc; sc.x = cvtpk_c(bflo(raw.x) * w0.x, bfhi(raw.x) * w0.y); sc.y = cvtpk_c(bflo(raw.y) * w0.z, bfhi(raw.y) * w0.w);
                sc.z = cvtpk_c(bflo(raw.z) * w1.x, bfhi(raw.z) * w1.y); sc.w = cvtpk_c(bflo(raw.w) * w1.z, bfhi(raw.w) * w1.w);
                Bf[pt] = __builtin_bit_cast(bf16x8, sc); }
#pragma unroll
            for (int nt2 = 0; nt2 < 2; ++nt2) { const bf16x8 Af = *(const LAS bf16x8*)(BT + (32 * (2 * nh + nt2) + cl) * XTS + 16 * ks + 8 * hi);
#pragma unroll
                for (int pt = 0; pt < 2; ++pt) acc[nt2][pt] = MFMA32(Af, Bf[pt], acc[nt2][pt]); }
        }
        bf16_t* ST = WSP(bf16_t, WS_ST) + (size_t)(c * 16 + hd) * (SP * SN);
#pragma unroll
        for (int nt2 = 0; nt2 < 2; ++nt2)
#pragma unroll
            for (int pt = 0; pt < 2; ++pt)
#pragma unroll
                for (int q = 0; q < 4; ++q) { const int n = 32 * (2 * nh + nt2) + 8 * q + 4 * hi, pp = 32 * pt + cl;
                    u32x2 wv; wv.x = cvtpk_c(acc[nt2][pt][4 * q], acc[nt2][pt][4 * q + 1]); wv.y = cvtpk_c(acc[nt2][pt][4 * q + 2], acc[nt2][pt][4 * q + 3]);
                    *(u32x2*)(ST + ((n >> 2) * SP + pp) * 4) = wv; }
        if (lane == 0 && nh == 0) WSP(float, WS_CDEC)[c * 16 + hd] = __expf(ACS[r * 64 + 63]);
    }
}
__device__ __forceinline__ void ssd_scan(PP pq, int tid) {
    bf16_t* ST = WSP(bf16_t, WS_ST); const float* CDEC = WSP(float, WS_CDEC);
    for (int e = blockIdx.x * NTHR + tid; e < (int)ST_CH; e += gridDim.x * NTHR) { const int hd = e >> 13; float s = 0.f;
        for (int c0 = 0; c0 < 256; c0 += 32) { float v[32], d[32];
#pragma unroll
            for (int k = 0; k < 32; ++k) { v[k] = bf2f(ST[(size_t)(c0 + k) * ST_CH + e]); d[k] = CDEC[(c0 + k) * 16 + hd]; }
#pragma unroll
            for (int k = 0; k < 32; ++k) { ST[(size_t)(c0 + k) * ST_CH + e] = f2bf1(s); s = s * d[k] + v[k]; } }
        { const int el = e & 8191, nb = el >> 8, pp = (el >> 2) & 63, j = el & 3; pq->out[O_PS + (size_t)hd * 8192 + pp * SN + 4 * nb + j] = s; } }
}
__device__ __forceinline__ void ssd_passC(PP pq, LAS unsigned char* lds, int tid, int lane, int wave) {
    LAS bf16_t* CN = (LAS bf16_t*)(lds + SD_CN); LAS bf16_t* BN = (LAS bf16_t*)(lds + SD_BN); LAS bf16_t* XT = (LAS bf16_t*)(lds + SD_XT);
    LAS float* ACS = (LAS float*)(lds + SD_ACS); LAS float* DTL = (LAS float*)(lds + SD_DTL);
    const bf16_t* Z = WSP(bf16_t, WS_Z); bf16_t* YS = WSP(bf16_t, WS_YS);
    for (int u = blockIdx.x; u < 1024; u += gridDim.x) { const int c = u >> 2, g = u & 3;
        __syncthreads(); ssd_stage(pq, lds, tid, lane, wave, 64 * c, 64, g, nullptr, 1); __syncthreads();
        const int r = wave >> 1, lt = wave & 1, hd = 4 * g + r, cl = lane & 31, hi = lane >> 5;
        const bf16_t* SPv = WSP(bf16_t, WS_ST) + (size_t)(c * 16 + hd) * (SP * SN);
        f32x16 acc[2];
#pragma unroll
        for (int b = 0; b < 2; ++b)
#pragma unroll
            for (int i = 0; i < 16; ++i) acc[b][i] = 0.f;
#pragma unroll
        for (int ks = 0; ks < 8; ++ks) { const bf16x8 Af = *(const LAS bf16x8*)(CN + (32 * lt + cl) * CNS + 16 * ks + 8 * hi);
#pragma unroll
            for (int pt = 0; pt < 2; ++pt) { const int nb0 = 4 * ks + 2 * hi, pp = 32 * pt + cl; const u32x2 lo2 = *(const u32x2*)(SPv + (nb0 * SP + pp) * 4), hi2 = *(const u32x2*)(SPv + ((nb0 + 1) * SP + pp) * 4);
                const u32x4 bw = (u32x4){lo2.x, lo2.y, hi2.x, hi2.y}; acc[pt] = MFMA32(Af, __builtin_bit_cast(bf16x8, bw), acc[pt]); } }
#pragma unroll
        for (int q = 0; q < 4; ++q) { const f32x4 a4 = *(const LAS f32x4*)(ACS + r * 64 + 32 * lt + 8 * q + 4 * hi);
#pragma unroll
            for (int j = 0; j < 4; ++j) { const float e = __expf(a4[j]); acc[0][4 * q + j] *= e; acc[1][4 * q + j] *= e; } }
        const float al = ACS[r * 64 + 32 * lt + cl];
        for (int st = 0; st <= lt; ++st) {
            f32x16 X;
#pragma unroll
            for (int i = 0; i < 16; ++i) X[i] = 0.f;
#pragma unroll
            for (int ks = 0; ks < 8; ++ks) { const bf16x8 Af = *(const LAS bf16x8*)(BN + (32 * st + cl) * CNS + 16 * ks + 8 * hi), Bf = *(const LAS bf16x8*)(CN + (32 * lt + cl) * CNS + 16 * ks + 8 * hi);
                X = MFMA32(Af, Bf, X); }
#pragma unroll
            for (int q = 0; q < 4; ++q) { const f32x4 as4 = *(const LAS f32x4*)(ACS + r * 64 + 32 * st + 8 * q + 4 * hi), ds4 = *(const LAS f32x4*)(DTL + r * 64 + 32 * st + 8 * q + 4 * hi);
#pragma unroll
                for (int j = 0; j < 4; ++j) { const int s = 32 * st + 8 * q + 4 * hi + j; const float v = X[4 * q + j] * __expf(fminf(al - as4[j], 0.f)) * ds4[j]; X[4 * q + j] = (s <= 32 * lt + cl) ? v : 0.f; } }
            bf16x8 pa[2];
#pragma unroll
            for (int s2 = 0; s2 < 2; ++s2) { u32x4 pw; pw.x = cvtpk_c(X[8 * s2], X[8 * s2 + 1]); pw.y = cvtpk_c(X[8 * s2 + 2], X[8 * s2 + 3]); pw.z = cvtpk_c(X[8 * s2 + 4], X[8 * s2 + 5]); pw.w = cvtpk_c(X[8 * s2 + 6], X[8 * s2 + 7]);
                pa[s2] = __builtin_bit_cast(bf16x8, pw); }
#pragma unroll
            for (int pt = 0; pt < 2; ++pt)
#pragma unroll
                for (int s2 = 0; s2 < 2; ++s2) { const LAS bf16_t* xp = XT + (r * 64 + 32 * pt + cl) * XTS + 32 * st + 16 * s2 + 4 * hi;
                    const u32x2 lo2 = *(const LAS u32x2*)xp, hi2 = *(const LAS u32x2*)(xp + 8); const u32x4 bw = (u32x4){lo2.x, lo2.y, hi2.x, hi2.y};
                    acc[pt] = MFMA32(pa[s2], __builtin_bit_cast(bf16x8, bw), acc[pt]); }
        }
        const float Dh = pq->in[I_DSKIP][hd]; float yv[2][16];
#pragma unroll
        for (int pt = 0; pt < 2; ++pt)
#pragma unroll
            for (int q = 0; q < 4; ++q) { const int pp = 32 * pt + cl, l0 = 32 * lt + 8 * q + 4 * hi;
                const u32x2 xw = *(const LAS u32x2*)(XT + (r * 64 + pp) * XTS + l0);
                yv[pt][4 * q] = acc[pt][4 * q] + Dh * bflo(xw.x); yv[pt][4 * q + 1] = acc[pt][4 * q + 1] + Dh * bfhi(xw.x); yv[pt][4 * q + 2] = acc[pt][4 * q + 2] + Dh * bflo(xw.y); yv[pt][4 * q + 3] = acc[pt][4 * q + 3] + Dh * bfhi(xw.y); }
        __syncthreads();
        LAS float* YL = (LAS float*)lds;
#pragma unroll
        for (int pt = 0; pt < 2; ++pt)
#pragma unroll
            for (int q = 0; q < 4; ++q)
#pragma unroll
                for (int j = 0; j < 4; ++j) YL[(32 * lt + 8 * q + 4 * hi + j) * YLS + r * 64 + 32 * pt + cl] = yv[pt][4 * q + j];
        __syncthreads();
        { const int l = tid >> 3, cs = (tid & 7) * 32; merge_thread<4, 8>(pq, 64 * c + l, g * 256 + cs, YL + l * YLS + cs); }
    }
}

__device__ __forceinline__ void ssd_seq4(PP pq, LAS unsigned char* lds, int tid, int lane, int wave, int b, int g) {
    const int row0 = SEQ + b * NSL;
    __syncthreads(); ssd_stage(pq, lds, tid, lane, wave, row0, NSL, g, pq->in[I_SCONV] + (size_t)b * 3 * CONVD, 1); __syncthreads();
    LAS bf16_t* CN = (LAS bf16_t*)(lds + SD_CN); LAS bf16_t* BN = (LAS bf16_t*)(lds + SD_BN); LAS bf16_t* XT = (LAS bf16_t*)(lds + SD_XT); LAS float* DTL = (LAS float*)(lds + SD_DTL);
    LAS float* YL = (LAS float*)(lds + 94208);
    const int r = tid >> 7, pp = (tid & 127) >> 1, nh = tid & 1, n0 = nh * 64, hd = 4 * g + r;
    const float A = -__expf(pq->in[I_ALOG][hd]), Dh = pq->in[I_DSKIP][hd];
    const float* sin_ = pq->in[I_SSM] + ((size_t)(b * SH + hd) * SP + pp) * SN + n0; float* sout = pq->out + O_SS + ((size_t)(b * SH + hd) * SP + pp) * SN + n0;
    float st[64];
#pragma unroll
    for (int j4 = 0; j4 < 16; ++j4) { const f32x4 v = *(const f32x4*)(sin_ + 4 * j4); st[4 * j4] = v.x; st[4 * j4 + 1] = v.y; st[4 * j4 + 2] = v.z; st[4 * j4 + 3] = v.w; }
#pragma unroll 1
    for (int t = 0; t < NSL; ++t) {
        const float dtv = DTL[r * 64 + t], dA = __expf(dtv * A), x = bf2f(XT[(r * 64 + pp) * XTS + t]), xdt = x * dtv; float y = 0.f;
#pragma unroll
        for (int j4 = 0; j4 < 16; ++j4) { const u32x2 bw = *(const LAS u32x2*)(BN + t * CNS + n0 + 4 * j4), cw2 = *(const LAS u32x2*)(CN + t * CNS + n0 + 4 * j4);
            st[4 * j4] = st[4 * j4] * dA + xdt * bflo(bw.x); y += bflo(cw2.x) * st[4 * j4];
            st[4 * j4 + 1] = st[4 * j4 + 1] * dA + xdt * bfhi(bw.x); y += bfhi(cw2.x) * st[4 * j4 + 1];
            st[4 * j4 + 2] = st[4 * j4 + 2] * dA + xdt * bflo(bw.y); y += bflo(cw2.y) * st[4 * j4 + 2];
            st[4 * j4 + 3] = st[4 * j4 + 3] * dA + xdt * bfhi(bw.y); y += bfhi(cw2.y) * st[4 * j4 + 3]; }
        y += __shfl_xor(y, 1);
        if (nh == 0) YL[t * YLS + r * 64 + pp] = y + Dh * x;
    }
#pragma unroll
    for (int j4 = 0; j4 < 16; ++j4) *(f32x4*)(sout + 4 * j4) = (f32x4){st[4 * j4], st[4 * j4 + 1], st[4 * j4 + 2], st[4 * j4 + 3]};
    __syncthreads();
    { const int t = tid >> 5, cs = (tid & 31) * 8; merge_thread<1, 32>(pq, row0 + t, g * 256 + cs, YL + t * YLS + cs); }
}
__device__ __forceinline__ void sample_ssd4_units(PP pq, LAS unsigned char* lds, int tid, int lane, int wave) {
    for (int v = blockIdx.x; v < NSB * SG; v += gridDim.x) ssd_seq4(pq, lds, tid, lane, wave, v >> 2, v & 3);
}

template <int EPI>
__device__ __forceinline__ void small_gemm(const bf16_t* __restrict__ A, const bf16_t* __restrict__ Bt, int N, int K, void* Out, int ldo, LAS unsigned char* lds, int tid, int lane, int wave) {
    const int nct = N / 64, nitems = 4 * nct, cl = lane & 31, hi = lane >> 5, kw = K / 8;
    LAS float* RED = (LAS float*)lds;
    for (int it = blockIdx.x; it < nitems; it += gridDim.x) { const int mt = it / nct, nt = it - mt * nct;
        f32x16 acc[2][2];
#pragma unroll
        for (int a = 0; a < 2; ++a)
#pragma unroll
            for (int b = 0; b < 2; ++b)
#pragma unroll
                for (int i = 0; i < 16; ++i) acc[a][b][i] = 0.f;
        const bf16_t* a0 = A + (size_t)(64 * mt + cl) * K + wave * kw + 8 * hi; const bf16_t* b0 = Bt + (size_t)(64 * nt + cl) * K + wave * kw + 8 * hi;
#pragma unroll 4
        for (int ks = 0; ks < kw / 16; ++ks) {
            const bf16x8 A0 = *(const bf16x8*)(a0 + 16 * ks), A1 = *(const bf16x8*)(a0 + (size_t)32 * K + 16 * ks), B0 = *(const bf16x8*)(b0 + 16 * ks), B1 = *(const bf16x8*)(b0 + (size_t)32 * K + 16 * ks);
            acc[0][0] = MFMA32(A0, B0, acc[0][0]); acc[0][1] = MFMA32(A0, B1, acc[0][1]); acc[1][0] = MFMA32(A1, B0, acc[1][0]); acc[1][1] = MFMA32(A1, B1, acc[1][1]); }
        __syncthreads();
#pragma unroll
        for (int a = 0; a < 2; ++a)
#pragma unroll
            for (int b = 0; b < 2; ++b)
#pragma unroll
                for (int i = 0; i < 16; ++i) RED[(wave * 64 + 32 * a + (i & 3) + 8 * (i >> 2) + 4 * hi) * 64 + 32 * b + cl] = acc[a][b][i];
        __syncthreads();
#pragma unroll
        for (int qd = 0; qd < 2; ++qd) { const int e = tid + NTHR * qd, row = e >> 4, c4 = (e & 15) * 4; f32x4 sum = (f32x4){0.f, 0.f, 0.f, 0.f};
#pragma unroll
            for (int w8 = 0; w8 < 8; ++w8) sum += *(const LAS f32x4*)(RED + (w8 * 64 + row) * 64 + c4);
            if (EPI == 0) *(f32x4*)((float*)Out + (size_t)(64 * mt + row) * ldo + 64 * nt + c4) = sum;
            else if (EPI == 2) { u32x2 wv; wv.x = cvtpk_c(sum.x, sum.y); wv.y = cvtpk_c(sum.z, sum.w); *(u32x2*)((bf16_t*)Out + (size_t)(64 * mt + row) * ldo + 64 * nt + c4) = wv; }
            else { const float r0 = fmaxf(sum.x, 0.f), r1 = fmaxf(sum.y, 0.f), r2 = fmaxf(sum.z, 0.f), r3 = fmaxf(sum.w, 0.f); u32x2 wv; wv.x = cvtpk_c(r0 * r0, r1 * r1); wv.y = cvtpk_c(r2 * r2, r3 * r3);
                *(u32x2*)((bf16_t*)Out + (size_t)(64 * mt + row) * ldo + 64 * nt + c4) = wv; } }
    }
    __syncthreads();
}

__device__ __forceinline__ void sample_attn_units(PP pq, LAS unsigned char* lds, int tid) {
    for (int u = blockIdx.x; u < 128; u += gridDim.x) sample_attn(pq, lds, tid, u >> 3, u & 7);
}
__device__ __forceinline__ void sample_ssd_units(PP pq, LAS unsigned char* lds, int tid) {
    for (int v = blockIdx.x; v < 256; v += gridDim.x) { const int b = v >> 4, hd = v & 15;
        ssd_seq(pq, lds, tid, SEQ + b * 16, NSL, 16, hd, pq->in[I_SSM] + (size_t)b * SH * SP * SN, pq->out + O_SS + (size_t)b * SH * SP * SN, pq->in[I_SCONV] + (size_t)b * 3 * CONVD); }
}

__device__ __forceinline__ void phase6(PP pq, int lane, int gw, int ngw) {
    const bf16_t* Qb = WSP(bf16_t, WS_Q); const bf16_t* Zb = WSP(bf16_t, WS_Z); bf16_t* H = WSP(bf16_t, WS_H); const float* sng = pq->in[I_SNG];
    for (int row = gw; row < R; row += ngw) {
        const bool smp = row >= SEQ; const int srow = row - SEQ; const size_t ro = (size_t)row * DM + 16 * lane;
        const bf16_t* gap = smp ? WSP(bf16_t, WS_GAS) + (size_t)srow * DM + 16 * lane : (const bf16_t*)(pq->out + O_YP) + ro;
        const bf16_t* gbp = smp ? WSP(bf16_t, WS_GBS) + (size_t)srow * DM + 16 * lane : (const bf16_t*)(pq->out + O_YP) + (size_t)SEQ * DM + ro;
        float ya[16], ys[16], ga[16], gb[16];
        unpack16(H + ro, ya); unpack16(WSP(bf16_t, WS_YS) + ro, ys); unpack16(gap, ga); unpack16(gbp, gb);
        float ss = 0.f;
#pragma unroll
        for (int e = 0; e < 16; ++e) ss += ys[e] * ys[e];
        ss += __shfl_xor(ss, 1); ss += __shfl_xor(ss, 2); ss += __shfl_xor(ss, 4); ss += __shfl_xor(ss, 8);
        const float rstd = 1.f / sqrtf(ss * (1.f / 256.f) + EPS);
        float m[16];
#pragma unroll
        for (int e4 = 0; e4 < 4; ++e4) { const f32x4 gg = *(const f32x4*)(sng + 16 * lane + 4 * e4);
#pragma unroll
            for (int j = 0; j < 4; ++j) { const int e = 4 * e4 + j; m[e] = sigmoidf_(ga[e]) * ya[e] + sigmoidf_(gb[e]) * (ys[e] * rstd * gg[j]); } }
        u32x4 w0, w1; w0.x = pk2(m[0], m[1]); w0.y = pk2(m[2], m[3]); w0.z = pk2(m[4], m[5]); w0.w = pk2(m[6], m[7]);
        w1.x = pk2(m[8], m[9]); w1.y = pk2(m[10], m[11]); w1.z = pk2(m[12], m[13]); w1.w = pk2(m[14], m[15]);
        *(u32x4*)(H + ro) = w0; *(u32x4*)(H + ro + 8) = w1;
    }
}

__device__ __forceinline__ void phase8(PP pq, int lane, int gw, int ngw) {
    const float* mod = WSP(float, WS_MOD); const bf16_t* MF = WSP(bf16_t, WS_MF); bf16_t* H = WSP(bf16_t, WS_H); const float* gqm = pq->in[I_GQM];
    for (int row0 = gw; row0 < R; row0 += 2 * ngw) {
        const int r1 = row0 + ngw; const bool has1 = r1 < R; int rr[2] = {row0, has1 ? r1 : row0};
        f32x4 v[2][4], xv[2][4], x1[2][4]; float rs[2], rs2[2]; const float* mr[2];
#pragma unroll
        for (int a = 0; a < 2; ++a) { const u32x2* mr4 = (const u32x2*)(MF + (size_t)rr[a] * DM) + lane; const f32x4* xr = (const f32x4*)xrow_ptr(pq, rr[a]) + lane; mr[a] = mod + (size_t)modrow(rr[a]) * 6144;
#pragma unroll
            for (int j = 0; j < 4; ++j) { { const u32x2 mw = __builtin_nontemporal_load(mr4 + 64 * j);     v[a][j] = (f32x4){bflo(mw.x), bfhi(mw.x), bflo(mw.y), bfhi(mw.y)}; } xv[a][j] = __builtin_nontemporal_load(xr + 64 * j); } }
#pragma unroll
        for (int a = 0; a < 2; ++a) rs[a] = 1.f / sqrtf(wave_sum(sumsq4(v[a])) * (1.f / DM) + EPS);
#pragma unroll
        for (int a = 0; a < 2; ++a) { f32x4* yr = (f32x4*)yrow_ptr(pq, rr[a]) + lane;
#pragma unroll
            for (int j = 0; j < 4; ++j) { const int c = 4 * lane + 256 * j; const f32x4 gt = *(const f32x4*)(mr[a] + 2048 + c), gg = *(const f32x4*)(gqm + c);
                x1[a][j] = xv[a][j] + gt * (v[a][j] * rs[a] * gg); if (a == 0 || has1) yr[64 * j] = x1[a][j]; } }
#pragma unroll
        for (int a = 0; a < 2; ++a) rs2[a] = 1.f / sqrtf(wave_sum(sumsq4(x1[a])) * (1.f / DM) + EPS);
        modnorm_store(x1[0], rs2[0], pq->in[I_GPF], mr[0] + 4096, mr[0] + 3072, H + (size_t)rr[0] * DM, lane);
        if (has1) modnorm_store(x1[1], rs2[1], pq->in[I_GPF], mr[1] + 4096, mr[1] + 3072, H + (size_t)rr[1] * DM, lane);
    }
}
__device__ __forceinline__ void phase11(PP pq, int lane, int gw, int ngw) {
    const float* mod = WSP(float, WS_MOD); const bf16_t* MF = WSP(bf16_t, WS_MF); const float* gqf = pq->in[I_GQF];
    for (int row0 = gw; row0 < R; row0 += 2 * ngw) {
        const int r1 = row0 + ngw; const bool has1 = r1 < R; int rr[2] = {row0, has1 ? r1 : row0};
        f32x4 v[2][4], yv[2][4]; float rs[2];
#pragma unroll
        for (int a = 0; a < 2; ++a) { const u32x2* fr4 = (const u32x2*)(MF + (size_t)rr[a] * DM) + lane; const f32x4* yr = (const f32x4*)yrow_ptr(pq, rr[a]) + lane;
#pragma unroll
            for (int j = 0; j < 4; ++j) { { const u32x2 fw = __builtin_nontemporal_load(fr4 + 64 * j); v[a][j] = (f32x4){bflo(fw.x), bfhi(fw.x), bflo(fw.y), bfhi(fw.y)}; } yv[a][j] = __builtin_nontemporal_load(yr + 64 * j); } }
#pragma unroll
        for (int a = 0; a < 2; ++a) rs[a] = 1.f / sqrtf(wave_sum(sumsq4(v[a])) * (1.f / DM) + EPS);
#pragma unroll
        for (int a = 0; a < 2; ++a) { if (a == 1 && !has1) break; f32x4* yr = (f32x4*)yrow_ptr(pq, rr[a]) + lane; const float* mr = mod + (size_t)modrow(rr[a]) * 6144;
#pragma unroll
            for (int j = 0; j < 4; ++j) { const int c = 4 * lane + 256 * j; const f32x4 gt = *(const f32x4*)(mr + 5120 + c), gg = *(const f32x4*)(gqf + c);
                yr[64 * j] = yv[a][j] + gt * (v[a][j] * rs[a] * gg); } }
    }
}

constexpr int NPHASE = 14;
__global__ void __launch_bounds__(NTHR, 2) fox_ssd_fwd(Params p) {
    extern __shared__ __attribute__((aligned(16))) unsigned char lds[];
    cg::grid_group grid = cg::this_grid();
    LAS unsigned char* ldsL = (LAS unsigned char*)lds;
    constexpr int BST_OFF = LDS_BYTES - 64;
    { PP q0 = kparams(); if (threadIdx.x < 2) ((volatile LAS unsigned*)(ldsL + BST_OFF))[threadIdx.x] = 0u; __syncthreads();
      if (q0->ph_hi - q0->ph_lo > 1) (void)xcd_barrier_post((unsigned*)(q0->ws + WS_BAR), (volatile LAS unsigned*)(ldsL + BST_OFF));
      if (q0->ph_lo < 0) grid.sync(); }
#define PV PP pq = kparams(); const int tid = launder_tid(), lane = tid & 63, wave = __builtin_amdgcn_readfirstlane(tid >> 6), gw = blockIdx.x * NWV + wave, ngw = gridDim.x * NWV; (void)lane; (void)gw; (void)ngw; (void)pq;
#ifndef ONLYP
#define ONLYP -1
#endif
#define IN(k) (in_phase(k) && (ONLYP < 0 || ONLYP == (k)))
#define GSYNC() do { XcdBarrier bar_; bar_.bar = (unsigned*)(kparams()->ws + WS_BAR); bar_.x = xb_xcc_id(); bar_.st = (volatile LAS unsigned*)(ldsL + BST_OFF); xcd_barrier(bar_); } while (0)
#define SEAM(k) do { if (IN(k) && IN((k) + 1)) GSYNC(); } while (0)
#ifndef REP_MASK
#define REP_MASK 0
#endif
#define PHASE(k, ...) do { if (IN(k)) { for (int rep_ = 0; rep_ <= ((REP_MASK >> (k)) & 1); ++rep_) { if (rep_) GSYNC(); PV __VA_ARGS__ } } SEAM(k); } while (0)
    PHASE(0, phase0(pq, ldsL, tid, lane, wave););
    PHASE(1, phase1(pq, lane, gw, ngw););
    PHASE(2, pg8::Gemm g{WSP(pg8::bf16_t, WS_H), WSP(pg8::bf16_t, WS_WTIN), R, NIN, DM}; pg8::StaticOrder S; S.init(R, NIN, gridDim.x, blockIdx.x); pg8::EpiIn E{0};
        pg8::gemm_phase<pg8::EpiIn, pg8::StaticOrder, true, true>(ldsL, g, S, E);
        { const int G = gridDim.x, nun = (R / 256) * (NIN / 256), rounds = (nun + G - 1) / G, r0 = nun - (rounds - 1) * G;
          __syncthreads();
          if (r0 >= G) late_transposes(pq, ldsL, tid, (int)blockIdx.x, G);
          else if ((int)blockIdx.x >= r0) late_transposes(pq, ldsL, tid, (int)blockIdx.x - r0, G - r0); });
    PHASE(3, phase3(pq, ldsL, tid, lane, wave););
    PHASE(4, phase4(pq, (char*)lds); __syncthreads(); sample_attn_units(pq, ldsL, tid););
    if (IN(5) && IN(6)) { for (int rep_ = 0; rep_ <= ((REP_MASK >> 5) & 1); ++rep_) { if (rep_) GSYNC(); { PV ssd_passA(pq, ldsL, tid, lane, wave); } GSYNC(); { PV ssd_scan(pq, tid); } } }
    else { if (IN(5)) { PV ssd_passA(pq, ldsL, tid, lane, wave); } if (IN(6)) { PV ssd_scan(pq, tid); } }
    SEAM(6);
    PHASE(7, ssd_passC(pq, ldsL, tid, lane, wave); sample_ssd4_units(pq, ldsL, tid, lane, wave););
    PHASE(9, small_gemm<2>(WSP(bf16_t, WS_H) + (size_t)SEQ * DM, WSP(bf16_t, WS_WTOUT), DM, DM, WSP(bf16_t, WS_MF) + (size_t)SEQ * DM, DM, ldsL, tid, lane, wave);
        pg8::Gemm g{WSP(pg8::bf16_t, WS_H), WSP(pg8::bf16_t, WS_WTOUT), SEQ, DM, DM}; pg8::StaticOrder S; S.init(SEQ, DM, gridDim.x, blockIdx.x); pg8::EpiBf E{WSP(pg8::bf16_t, WS_MF), DM};
        pg8::gemm_phase<pg8::EpiBf, pg8::StaticOrder, true, true>(ldsL, g, S, E););
    PHASE(10, phase8(pq, lane, gw, ngw););
    PHASE(11, small_gemm<1>(WSP(bf16_t, WS_H) + (size_t)SEQ * DM, WSP(bf16_t, WS_WTUP), DFF, DM, WSP(bf16_t, WS_HID) + (size_t)SEQ * DFF, DFF, ldsL, tid, lane, wave);
        pg8::Gemm g{WSP(pg8::bf16_t, WS_H), WSP(pg8::bf16_t, WS_WTUP), SEQ, DFF, DM}; pg8::StaticOrder S; S.init(SEQ, DFF, gridDim.x, blockIdx.x); pg8::EpiRelu2 E{WSP(pg8::bf16_t, WS_HID), DFF};
        pg8::gemm_phase<pg8::EpiRelu2, pg8::StaticOrder, true, true>(ldsL, g, S, E););
    PHASE(12, small_gemm<2>(WSP(bf16_t, WS_HID) + (size_t)SEQ * DFF, WSP(bf16_t, WS_WTDN), DM, DFF, WSP(bf16_t, WS_MF) + (size_t)SEQ * DM, DM, ldsL, tid, lane, wave);
        pg8::Gemm g{WSP(pg8::bf16_t, WS_HID), WSP(pg8::bf16_t, WS_WTDN), SEQ, DM, DFF}; pg8::StaticOrder S; S.init(SEQ, DM, gridDim.x, blockIdx.x); pg8::EpiBf E{WSP(pg8::bf16_t, WS_MF), DM};
        pg8::gemm_phase<pg8::EpiBf, pg8::StaticOrder, true, true>(ldsL, g, S, E););
    if (IN(13)) { PV phase11(pq, lane, gw, ngw); }
#undef IN
#undef SEAM
}

#ifndef MK_PER_PHASE
#define MK_PER_PHASE 0
#endif
extern "C" void kernel_launch(void* const* d_in, const int* in_sizes, int n_in, void* d_out, int out_size, void* d_ws, size_t ws_size, hipStream_t stream) {
    static int grid = 0;
    if (grid == 0) {
        if (n_in != 26 || out_size != (int)O_END || ws_size < WS_END) { fprintf(stderr, "kernel_launch: unexpected shapes n_in %d out %d ws %zu (need %zu)\n", n_in, out_size, ws_size, (size_t)WS_END); grid = -1; return; }
        int dev = 0, cus = 0, per_cu = 0;
        (void)hipGetDevice(&dev);
        if (hipDeviceGetAttribute(&cus, hipDeviceAttributeMultiprocessorCount, dev) != hipSuccess || cus <= 0) cus = 256;
        if (hipFuncSetAttribute((const void*)fox_ssd_fwd, hipFuncAttributeMaxDynamicSharedMemorySize, LDS_BYTES) != hipSuccess) fprintf(stderr, "kernel_launch: hipFuncSetAttribute failed\n");
        if (hipOccupancyMaxActiveBlocksPerMultiprocessor(&per_cu, (const void*)fox_ssd_fwd, NTHR, LDS_BYTES) != hipSuccess || per_cu < 1) { fprintf(stderr, "kernel_launch: occupancy query says %d\n", per_cu); per_cu = 1; }
        (void)hipGetLastError();
        grid = cus * per_cu;
    }
    if (grid < 0) return;
    if (hipMemsetAsync((char*)d_ws + WS_BAR, 0, 16384, stream) != hipSuccess) { fprintf(stderr, "kernel_launch: memset of barrier words failed\n"); return; }
    Params p{};
    for (int i = 0; i < 26; ++i) p.in[i] = (const float*)d_in[i];
    p.out = (float*)d_out; p.ws = (unsigned char*)d_ws;
#if MK_PER_PHASE
    for (int k = 0; k < NPHASE; ++k) { p.ph_lo = k; p.ph_hi = k + 1; hipLaunchKernelGGL(fox_ssd_fwd, dim3(grid), dim3(NTHR), LDS_BYTES, stream, p); }
#else
    p.ph_lo = 0; p.ph_hi = NPHASE;
    void* args[] = {&p};
    hipError_t e = hipLaunchCooperativeKernel((const void*)fox_ssd_fwd, dim3(grid), dim3(NTHR), args, LDS_BYTES, stream);
    if (e != hipSuccess) fprintf(stderr, "kernel_launch: cooperative launch failed: %s (grid %d)\n", hipGetErrorString(e), grid);
#endif
}
```

```cpp
#include <hip/hip_runtime.h>
#include <hip/hip_bf16.h>
#include <hip/hip_cooperative_groups.h>
#include <cstdio>
#include <cstdint>
namespace cg = cooperative_groups;

namespace pg8 {
#define PG8_LAS __attribute__((address_space(3)))
typedef unsigned short bf16_t;
typedef short bf16x8 __attribute__((ext_vector_type(8)));
typedef float f32x4 __attribute__((ext_vector_type(4)));
typedef unsigned u32x4 __attribute__((ext_vector_type(4)));
constexpr int BM = 256, BK = 64, HALF = 128, HTB = HALF * BK * 2  , STAGE_BYTES = 8 * HTB, NXCD = 8, WGM = 8;

__host__ __device__ __forceinline__ int lds_byte(int r, int c) { const int st = (r >> 4) * 2 + (c >> 5), rr = r & 15, cc = c & 31, ob = rr * 64 + cc * 2; return st * 1024 + (ob ^ (((ob >> 9) & 1) << 5)); }
__host__ __device__ __forceinline__ void stage_rc(int b, int& R, int& C) { const int st = b / 1024, sb = b % 1024, swz = sb ^ (((sb >> 9) & 1) << 5); R = (st >> 1) * 16 + swz / 64; C = (st & 1) * 32 + (swz % 64) / 2; }
__host__ __device__ __forceinline__ int perm32(int rho) { const int n = rho >> 4, i = rho & 15; return 8 * (i >> 2) + 4 * n + (i & 3); }

struct Unit { int pm, pn; };
struct Gemm { const bf16_t* A; const bf16_t* Bt; int M, N, K; };

struct StaticOrder {
    int nM, nN, nwg, G, c;
    __host__ __device__ void init(int M, int N, int G_, int c_) { nM = M / BM; nN = N / BM; nwg = nM * nN; G = G_; c = c_; }
    __host__ __device__ bool next(int i, Unit& u) const {
        const long L = (long)i * G + c; if (L >= nwg) return false;
        int wgid = (int)L; { const int q = nwg / NXCD, r = nwg % NXCD, xcd = wgid % NXCD, off = wgid / NXCD; wgid = (xcd < r ? xcd * (q + 1) : r * (q + 1) + (xcd - r) * q) + off; }
        const int nig = WGM * nN, gid = wgid / nig, fm = gid * WGM, gsz = (nM - fm) < WGM ? (nM - fm) : WGM;
        u.pm = fm + ((wgid % nig) % gsz); u.pn = (wgid % nig) / gsz; return true;
    }
    __device__ __forceinline__ void a_ready(const Unit&) const {}
    __device__ __forceinline__ void done(const Unit&) const {}
};

__device__ __forceinline__ unsigned cvt_pk_bf16(float lo, float hi) { unsigned r; asm volatile("v_cvt_pk_bf16_f32 %0, %1, %2" : "=v"(r) : "v"(lo), "v"(hi)); return r; }
template <class Epi, class Sched, bool ALIGN_EPI = false, bool SP2 = false>
__device__ __forceinline__ void gemm_phase(PG8_LAS unsigned char* lds, const Gemm g, const Sched& S, const Epi& E) {
    const int tid = threadIdx.x, wid = __builtin_amdgcn_readfirstlane(tid >> 6), lane = tid & 63, wr = wid >> 2, wc = wid & 3, fr = lane & 15, fq = lane >> 4;
    const int K = g.K, nt = K / BK;
    unsigned voffA[2], voffB[2];
#pragma unroll
    for (int i = 0; i < 2; ++i) { int R, C; stage_rc(tid * 16 + i * 8192, R, C); const int Rb = Epi::PERM ? ((R & ~31) + perm32(R & 31)) : R;
        voffA[i] = (unsigned)(R * K + C) * 2u; voffB[i] = (unsigned)(Rb * K + C) * 2u; }
    const size_t kstep = (size_t)(BK * 2);
    const size_t hstep = (size_t)HALF * K * 2;
    const size_t tstep = 2 * hstep;
    const unsigned ldsw = (unsigned)wid * 1024u;
    const int aoff = lds_byte(wr * 64 + fr, fq * 8), boff = lds_byte(wc * 32 + fr, fq * 8);
#define PG8_SA(b, h) (((b) * 2 + (h)) * HTB)
#define PG8_SB(b, h) ((4 + (b) * 2 + (h)) * HTB)
#define PG8_STAGE(bufoff, gbase, voff) do { _Pragma("unroll") for (int _i = 0; _i < 2; ++_i) \
        __builtin_amdgcn_global_load_lds((const unsigned*)((const char*)(gbase) + (voff)[_i]), (PG8_LAS unsigned*)(lds + (bufoff) + ldsw + _i * 8192), 16, 0, 0); } while (0)
#define PG8_LDA(dst, b, h) do { _Pragma("unroll") for (int m = 0; m < 4; ++m) _Pragma("unroll") for (int k = 0; k < 2; ++k) dst[m][k] = *(const PG8_LAS bf16x8*)(lds + PG8_SA(b, h) + aoff + m * 2048 + k * 1024); } while (0)
#define PG8_LDB(dst, b, h) do { _Pragma("unroll") for (int n = 0; n < 2; ++n) _Pragma("unroll") for (int k = 0; k < 2; ++k) dst[n][k] = *(const PG8_LAS bf16x8*)(lds + PG8_SB(b, h) + boff + n * 2048 + k * 1024); } while (0)
#define PG8_MMA(ai, bj, At, Bt) do { __builtin_amdgcn_s_setprio(1); _Pragma("unroll") for (int m = 0; m < 4; ++m) _Pragma("unroll") for (int n = 0; n < 2; ++n) _Pragma("unroll") for (int k = 0; k < 2; ++k) \
        acc[ai][bj][m][n] = __builtin_amdgcn_mfma_f32_16x16x32_bf16(Bt[n][k], At[m][k], acc[ai][bj][m][n], 0, 0, 0); __builtin_amdgcn_s_setprio(0); } while (0)
#define PG8_WAIT_V(n) asm volatile("s_waitcnt vmcnt(" #n ")" ::: "memory")
#define PG8_WAIT_L(n) asm volatile("s_waitcnt lgkmcnt(" #n ")" ::: "memory")
#define PG8_BAR __builtin_amdgcn_s_barrier()
#define PG8_SCHED __builtin_amdgcn_sched_barrier(0)
    Unit cur, nxt; int ui = 0;
    if (!S.next(0, cur)) return;
    f32x4 acc[2][2][4][2];
#pragma unroll
    for (int a = 0; a < 2; ++a)
#pragma unroll
        for (int b = 0; b < 2; ++b)
#pragma unroll
            for (int m = 0; m < 4; ++m)
#pragma unroll
                for (int n = 0; n < 2; ++n) acc[a][b][m][n] = (f32x4){0.f, 0.f, 0.f, 0.f};
    bf16x8 At[4][2], B0[2][2], B1[2][2];
    const char* cA = (const char*)g.A + (size_t)cur.pm * tstep; const char* cB = (const char*)g.Bt + (size_t)cur.pn * tstep;
    S.a_ready(cur);
    if constexpr (SP2) {
        PG8_STAGE(PG8_SB(0, 0), cB, voffB); PG8_STAGE(PG8_SB(0, 1), cB + hstep, voffB); PG8_STAGE(PG8_SA(0, 0), cA, voffA); PG8_STAGE(PG8_SA(0, 1), cA + hstep, voffA);
        if (wr == 1) PG8_BAR;
        PG8_WAIT_V(2); PG8_BAR;
        PG8_STAGE(PG8_SB(1, 0), cB + kstep, voffB); PG8_STAGE(PG8_SA(1, 0), cA + kstep, voffA); PG8_STAGE(PG8_SB(1, 1), cB + hstep + kstep, voffB);
        PG8_WAIT_V(6); PG8_BAR;
    } else {
        PG8_STAGE(PG8_SB(0, 0), cB, voffB); PG8_STAGE(PG8_SA(0, 0), cA, voffA); PG8_STAGE(PG8_SB(0, 1), cB + hstep, voffB); PG8_STAGE(PG8_SA(0, 1), cA + hstep, voffA);
        if (wr == 1) PG8_BAR;
        PG8_WAIT_V(4); PG8_BAR;
        PG8_STAGE(PG8_SB(1, 0), cB + kstep, voffB); PG8_STAGE(PG8_SA(1, 0), cA + kstep, voffA); PG8_STAGE(PG8_SB(1, 1), cB + hstep + kstep, voffB);
        PG8_WAIT_V(6); PG8_BAR;
    }
    for (;;) {
        const bool has_next = S.next(ui + 1, nxt);
        const char* nA = has_next ? (const char*)g.A + (size_t)nxt.pm * tstep : cA; const char* nB = has_next ? (const char*)g.Bt + (size_t)nxt.pn * tstep : cB;
        for (int t = 0; t < nt; t += 2) {
            const bool last = (t == nt - 2);
            const char* a1 = cA + (size_t)(t + 1) * kstep;
            const char* a2 = last ? nA : cA + (size_t)(t + 2) * kstep; const char* b2 = last ? nB : cB + (size_t)(t + 2) * kstep;
            const char* a3 = a2 + kstep; const char* b3 = b2 + kstep;
            if (last && has_next) S.a_ready(nxt);
            if constexpr (SP2) {
            PG8_LDB(B0, 0, 0); PG8_LDB(B1, 0, 1); PG8_SCHED; PG8_LDA(At, 0, 0); PG8_STAGE(PG8_SA(1, 1), a1 + hstep, voffA);
            PG8_WAIT_V(8); PG8_WAIT_L(0); PG8_BAR; PG8_MMA(0, 0, At, B0); PG8_MMA(0, 1, At, B1); PG8_BAR; PG8_SCHED;
            PG8_LDA(At, 0, 1); PG8_STAGE(PG8_SB(0, 0), b2, voffB); PG8_STAGE(PG8_SB(0, 1), b2 + hstep, voffB); PG8_STAGE(PG8_SA(0, 0), a2, voffA);
            PG8_WAIT_V(8); PG8_WAIT_L(0); PG8_BAR; PG8_MMA(1, 0, At, B0); PG8_MMA(1, 1, At, B1); PG8_BAR; PG8_SCHED;
            PG8_LDB(B0, 1, 0); PG8_LDB(B1, 1, 1); PG8_SCHED; PG8_LDA(At, 1, 0); PG8_STAGE(PG8_SA(0, 1), a2 + hstep, voffA);
            PG8_WAIT_V(8); PG8_WAIT_L(0); PG8_BAR; PG8_MMA(0, 0, At, B0); PG8_MMA(0, 1, At, B1); PG8_BAR; PG8_SCHED;
            PG8_LDA(At, 1, 1); PG8_STAGE(PG8_SB(1, 0), b3, voffB); PG8_STAGE(PG8_SB(1, 1), b3 + hstep, voffB); PG8_STAGE(PG8_SA(1, 0), a3, voffA);
            PG8_WAIT_V(8); PG8_WAIT_L(0); PG8_BAR; PG8_MMA(1, 0, At, B0); PG8_MMA(1, 1, At, B1); PG8_BAR; PG8_SCHED;
            } else {
            PG8_LDB(B0, 0, 0); PG8_SCHED; PG8_LDA(At, 0, 0); PG8_STAGE(PG8_SA(1, 1), a1 + hstep, voffA);
            PG8_WAIT_L(8); PG8_BAR; PG8_WAIT_L(0); PG8_MMA(0, 0, At, B0); PG8_BAR; PG8_SCHED;
            PG8_LDB(B1, 0, 1); PG8_STAGE(PG8_SB(0, 0), b2, voffB);
            PG8_BAR; PG8_WAIT_L(0); PG8_MMA(0, 1, At, B1); PG8_BAR;
            PG8_LDA(At, 0, 1); PG8_STAGE(PG8_SA(0, 0), a2, voffA);
            PG8_BAR; PG8_WAIT_L(0); PG8_MMA(1, 0, At, B0); PG8_BAR; PG8_SCHED;
            PG8_STAGE(PG8_SB(0, 1), b2 + hstep, voffB);
            PG8_WAIT_V(6); PG8_BAR; PG8_MMA(1, 1, At, B1); PG8_BAR;
            PG8_LDB(B0, 1, 0); PG8_SCHED; PG8_LDA(At, 1, 0); PG8_STAGE(PG8_SA(0, 1), a2 + hstep, voffA);
            PG8_WAIT_L(8); PG8_BAR; PG8_WAIT_L(0); PG8_MMA(0, 0, At, B0); PG8_BAR; PG8_SCHED;
            PG8_LDB(B1, 1, 1); PG8_STAGE(PG8_SB(1, 0), b3, voffB);
            PG8_BAR; PG8_WAIT_L(0); PG8_MMA(0, 1, At, B1); PG8_BAR;
            PG8_LDA(At, 1, 1); PG8_STAGE(PG8_SA(1, 0), a3, voffA);
            PG8_BAR; PG8_WAIT_L(0); PG8_MMA(1, 0, At, B0); PG8_BAR; PG8_SCHED;
            PG8_STAGE(PG8_SB(1, 1), b3 + hstep, voffB);
            PG8_WAIT_V(6); PG8_BAR; PG8_MMA(1, 1, At, B1); PG8_BAR;
            }
        }
        if constexpr (ALIGN_EPI) { if (wr == 0) PG8_BAR; }
        if constexpr (!Epi::AFTER_DRAIN) { E(acc, cur, wr, wc, fr, fq); S.done(cur); }
        if (!has_next) break;
#pragma unroll
        for (int a = 0; a < 2; ++a)
#pragma unroll
            for (int b = 0; b < 2; ++b)
#pragma unroll
                for (int m = 0; m < 4; ++m)
#pragma unroll
                    for (int n = 0; n < 2; ++n) acc[a][b][m][n] = (f32x4){0.f, 0.f, 0.f, 0.f};
        cur = nxt; cA = nA; cB = nB; ++ui;
        if constexpr (ALIGN_EPI) { if (wr == 1) PG8_BAR; }
    }
    PG8_WAIT_V(0);
    if constexpr (!ALIGN_EPI) { if (wr == 0) PG8_BAR; }
    PG8_BAR;
    if constexpr (Epi::AFTER_DRAIN) { E.fused(acc, cur, wr, wc, fr, fq, lds, wid, lane); S.done(cur); }
#undef PG8_SA
#undef PG8_SB
#undef PG8_STAGE
#undef PG8_LDA
#undef PG8_LDB
#undef PG8_MMA
#undef PG8_WAIT_V
#undef PG8_WAIT_L
#undef PG8_BAR
#undef PG8_SCHED
}
}

constexpr int DM = 1024, SEQ = 16384, NSB = 16, NSL = 16, PAST = 1024, NSR = NSB * NSL  , R = SEQ + NSR  ;
constexpr int NH = 8, HD = 128, SH = 16, SP = 64, SG = 4, SN = 128, CONVD = 2048, DFF = 4096;
constexpr int NIN = 8448;
constexpr int TKS = PAST + NSL;
constexpr float EPS = 1e-6f;
constexpr float FOX_SCALE = 0.08838834764831845f, INV_SCALE = 11.313708498984761f;
constexpr size_t O_YP = 0, O_YS = O_YP + (size_t)SEQ * DM, O_PK = O_YS + (size_t)NSR * DM, O_PV = O_PK + (size_t)SEQ * DM, O_PL = O_PV + (size_t)SEQ * DM,
                 O_PC = O_PL + (size_t)SEQ * NH, O_PS = O_PC + 3 * CONVD, O_SK = O_PS + (size_t)SH * SP * SN, O_SV = O_SK + (size_t)NSR * DM, O_SL = O_SV + (size_t)NSR * DM,
                 O_SC = O_SL + (size_t)NSR * NH, O_SS = O_SC + (size_t)NSB * 3 * CONVD, O_END = O_SS + (size_t)NSB * SH * SP * SN;
static_assert(O_END == 53583872, "output size");
constexpr size_t WS_WTIN = 0, WS_WTOUT = WS_WTIN + (size_t)NIN * DM * 2, WS_WTUP = WS_WTOUT + (size_t)DM * DM * 2, WS_WTDN = WS_WTUP + (size_t)DFF * DM * 2,
                 WS_MOD = WS_WTDN + (size_t)DM * DFF * 2, WS_LOGF = WS_MOD + 17 * 6144 * 4, WS_DT = WS_LOGF + (size_t)R * 8 * 4, WS_FSP = WS_DT + (size_t)R * 16 * 4,
                 WS_FSS = WS_FSP + (size_t)NH * SEQ * 4, WS_GAS = WS_FSS + (size_t)128 * TKS * 4, WS_GBS = WS_GAS + (size_t)NSR * DM * 2, WS_H = WS_GBS + (size_t)NSR * DM * 2,
                 WS_Q = WS_H + (size_t)R * DM * 2, WS_K = WS_Q + (size_t)R * DM * 2, WS_V = WS_K + (size_t)R * DM * 2, WS_Z = WS_V + (size_t)R * DM * 2,
                 WS_XBC = WS_Z + (size_t)R * DM * 2, WS_CDEC = WS_XBC + (size_t)R * CONVD * 2, WS_NRM = WS_CDEC + 256 * 16 * 4, WS_BAR = WS_NRM + 256, WS_GQ = WS_BAR + 16384, WS_GD = WS_GQ + (size_t)NH * SEQ * 4, WS_LOGFT = WS_GD + (size_t)NH * SEQ * 4, WS_END = WS_LOGFT + (size_t)NH * SEQ * 4;
constexpr size_t WS_ST = WS_K;
static_assert((size_t)256 * 16 * 64 * 128 * 2 <= WS_Z - WS_K, "state overlay");
constexpr size_t WS_YS = WS_Q;
constexpr size_t WS_HID = WS_Q;
constexpr size_t WS_MF = WS_XBC;
static_assert(WS_MOD % 256 == 0 && WS_H % 256 == 0 && WS_FSS % 256 == 0 && WS_GAS % 256 == 0, "align");
constexpr int LDS_BYTES = 147456;
constexpr int NTHR = 512, NWV = 8;

#define LAS __attribute__((address_space(3)))
typedef unsigned short bf16_t;
typedef float f32x4 __attribute__((ext_vector_type(4)));
typedef unsigned u32x4 __attribute__((ext_vector_type(4)));
typedef unsigned u32x2 __attribute__((ext_vector_type(2)));
typedef short bf16x8 __attribute__((ext_vector_type(8)));

__device__ __forceinline__ unsigned pk2(float lo, float hi) { return pg8::cvt_pk_bf16(lo, hi); }
__device__ __forceinline__ float bf2f(unsigned short b) { return __uint_as_float(((unsigned)b) << 16); }
__device__ __forceinline__ float bflo(unsigned w) { return __uint_as_float(w << 16); }
__device__ __forceinline__ float bfhi(unsigned w) { return __uint_as_float(w & 0xffff0000u); }
__device__ __forceinline__ float wave_sum(float v) {
#pragma unroll
    for (int o = 1; o < 64; o <<= 1) v += __shfl_xor(v, o);
    return v;
}
__device__ __forceinline__ float sigmoidf_(float x) { return __builtin_amdgcn_rcpf(1.f + __expf(-x)); }
__device__ __forceinline__ float siluf_(float x) { return x * __builtin_amdgcn_rcpf(1.f + __expf(-x)); }
__device__ __forceinline__ float softplusf_(float x) { return fmaxf(x, 0.f) + __logf(1.f + __expf(-fabsf(x))); }
__device__ __forceinline__ float logsigmoidf_(float x) { return fminf(x, 0.f) - __logf(1.f + __expf(-fabsf(x))); }

struct Params { const float* in[26]; float* out; unsigned char* ws; int ph_lo, ph_hi; };
typedef const __attribute__((address_space(4))) Params* PP;
__device__ __forceinline__ PP kparams() { PP q = (PP)__builtin_amdgcn_kernarg_segment_ptr(); asm volatile("" : "+s"(q)); return q; }
__device__ __forceinline__ bool in_phase(int k) { PP q = kparams(); return q->ph_lo <= k && k < q->ph_hi; }
__device__ __forceinline__ int launder_tid() { int t = threadIdx.x; asm volatile("" : "+v"(t)); return t; }
enum { I_XP = 0, I_XS, I_CP, I_CS, I_CK, I_CV, I_CLF, I_SCONV, I_SSM, I_WADA, I_BADA, I_GPM, I_GQM, I_GPF, I_GQF, I_WIN, I_BF, I_CW, I_CB, I_DTB, I_ALOG, I_DSKIP, I_SNG, I_WOUT, I_WUP, I_WDN };

namespace pg8 {
struct EpiIn {
    static constexpr bool PERM = true, AFTER_DRAIN = false;
    int dummy;
    __device__ __forceinline__ void operator()(const f32x4 (&acc)[2][2][4][2], const Unit& u, int wr, int wc, int fr, int fq) const {
        const int pn = u.pn;
        const int seg = pn < 16 ? (pn >> 2) : (pn < 24 ? 4 : (pn < 28 ? 5 : (pn < 32 ? 6 : 7)));
        switch (seg) {
            case 0: body<0>(acc, u, wr, wc, fr, fq); break; case 1: body<1>(acc, u, wr, wc, fr, fq); break; case 2: body<2>(acc, u, wr, wc, fr, fq); break; case 3: body<3>(acc, u, wr, wc, fr, fq); break;
            case 4: body<4>(acc, u, wr, wc, fr, fq); break; case 5: body<5>(acc, u, wr, wc, fr, fq); break; case 6: body<6>(acc, u, wr, wc, fr, fq); break; default: body<7>(acc, u, wr, wc, fr, fq); break; }
    }
    template <int seg>
    __device__ __forceinline__ void body(const f32x4 (&acc)[2][2][4][2], const Unit& u, int wr, int wc, int fr, int fq) const {
        PP pq = kparams(); unsigned char* ws = pq->ws; float* out = pq->out; const float* b_f = pq->in[I_BF]; const float* dt_bias = pq->in[I_DTB];
        const int pn = u.pn;
        constexpr int segbase = seg < 4 ? seg * 1024 : (seg == 4 ? 4096 : (seg == 5 ? 6144 : (seg == 6 ? 7168 : 8192)));
#pragma unroll
        for (int ai = 0; ai < 2; ++ai)
#pragma unroll
            for (int m = 0; m < 4; ++m) {
                const int row = u.pm * BM + ai * HALF + wr * 64 + m * 16 + fr;
                const bool smp = row >= SEQ; const int srow = row - SEQ;
#pragma unroll
                for (int bj = 0; bj < 2; ++bj) {
                    const int c = pn * BM + bj * HALF + wc * 32 + 8 * fq - segbase;
                    const f32x4 v0 = acc[ai][bj][m][0], v1 = acc[ai][bj][m][1];
                    u32x4 w; w.x = cvt_pk_bf16(v0[0], v0[1]); w.y = cvt_pk_bf16(v0[2], v0[3]); w.z = cvt_pk_bf16(v1[0], v1[1]); w.w = cvt_pk_bf16(v1[2], v1[3]);
                    if (seg == 0) { *(u32x4*)((bf16_t*)(ws + WS_Q) + (size_t)row * DM + c) = w; }
                    else if (seg == 1 || seg == 2) {
                        *(u32x4*)((bf16_t*)(ws + (seg == 1 ? WS_K : WS_V)) + (size_t)row * DM + c) = w;
                        float* o = smp ? out + (seg == 1 ? O_SK : O_SV) + (size_t)srow * DM + c : out + (seg == 1 ? O_PK : O_PV) + (size_t)row * DM + c;
                        *(f32x4*)o = v0; *(f32x4*)(o + 4) = v1;
                    }
                    else if (seg == 3) { *(u32x4*)((bf16_t*)(ws + WS_Z) + (size_t)row * DM + c) = w; }
                    else if (seg == 4) {
                        *(u32x4*)((bf16_t*)(ws + WS_XBC) + (size_t)row * CONVD + c) = w;
                        if (!smp) { if (row >= SEQ - 3) { float* o = out + O_PC + (size_t)(row - (SEQ - 3)) * CONVD + c; *(f32x4*)o = v0; *(f32x4*)(o + 4) = v1; } }
                        else { const int i = srow & 15, b = srow >> 4; if (i >= 13) { float* o = out + O_SC + (size_t)(b * 3 + i - 13) * CONVD + c; *(f32x4*)o = v0; *(f32x4*)(o + 4) = v1; } }
                    }
                    else if (seg == 5 || seg == 6) {
                        bf16_t* d = smp ? (bf16_t*)(ws + (seg == 5 ? WS_GAS : WS_GBS)) + (size_t)srow * DM + c
                                        : (bf16_t*)(out + O_YP) + (seg == 5 ? (size_t)0 : (size_t)SEQ * DM) + (size_t)row * DM + c;
                        *(u32x4*)d = w;
                    }
                    else {
                        if (c == 0) {
                            float lf[8];
#pragma unroll
                            for (int j = 0; j < 4; ++j) { lf[j] = logsigmoidf_(v0[j] + b_f[j]); lf[4 + j] = logsigmoidf_(v1[j] + b_f[4 + j]); }
                            float* o1 = (float*)(ws + WS_LOGF) + (size_t)row * 8; float* o2 = smp ? out + O_SL + (size_t)srow * 8 : out + O_PL + (size_t)row * 8;
                            *(f32x4*)o1 = (f32x4){lf[0], lf[1], lf[2], lf[3]}; *(f32x4*)(o1 + 4) = (f32x4){lf[4], lf[5], lf[6], lf[7]};
                            *(f32x4*)o2 = (f32x4){lf[0], lf[1], lf[2], lf[3]}; *(f32x4*)(o2 + 4) = (f32x4){lf[4], lf[5], lf[6], lf[7]};
                            if (!smp) { float* ot = (float*)(ws + WS_LOGFT) + row;
#pragma unroll
                                for (int j = 0; j < 8; ++j) ot[(size_t)j * SEQ] = lf[j]; }
                        } else if (c == 8 || c == 16) {
                            float d[8];
#pragma unroll
                            for (int j = 0; j < 4; ++j) { d[j] = softplusf_(v0[j] + dt_bias[c - 8 + j]); d[4 + j] = softplusf_(v1[j] + dt_bias[c - 8 + 4 + j]); }
                            float* o1 = (float*)(ws + WS_DT) + (size_t)row * 16 + (c - 8);
                            *(f32x4*)o1 = (f32x4){d[0], d[1], d[2], d[3]}; *(f32x4*)(o1 + 4) = (f32x4){d[4], d[5], d[6], d[7]};
                        }
                    }
                }
            }
    }
};
struct EpiF32 {
    static constexpr bool PERM = false, AFTER_DRAIN = false;
    float* O; int ldc;
    __device__ __forceinline__ void operator()(const f32x4 (&acc)[2][2][4][2], const Unit& u, int wr, int wc, int fr, int fq) const {
#pragma unroll
        for (int ai = 0; ai < 2; ++ai)
#pragma unroll
            for (int m = 0; m < 4; ++m) { float* rowp = O + (size_t)(u.pm * BM + ai * HALF + wr * 64 + m * 16 + fr) * ldc + u.pn * BM + wc * 32 + 4 * fq;
#pragma unroll
                for (int bj = 0; bj < 2; ++bj)
#pragma unroll
                    for (int n = 0; n < 2; ++n) *(f32x4*)(rowp + bj * HALF + n * 16) = acc[ai][bj][m][n]; }
    }
};
struct EpiBf {
    static constexpr bool PERM = true, AFTER_DRAIN = false;
    bf16_t* O; int ldc;
    __device__ __forceinline__ void operator()(const f32x4 (&acc)[2][2][4][2], const Unit& u, int wr, int wc, int fr, int fq) const {
#pragma unroll
        for (int ai = 0; ai < 2; ++ai)
#pragma unroll
            for (int m = 0; m < 4; ++m) { bf16_t* rowp = O + (size_t)(u.pm * BM + ai * HALF + wr * 64 + m * 16 + fr) * ldc + u.pn * BM + wc * 32 + 8 * fq;
#pragma unroll
                for (int bj = 0; bj < 2; ++bj) { const f32x4 v0 = acc[ai][bj][m][0], v1 = acc[ai][bj][m][1];
                    u32x4 w; w.x = cvt_pk_bf16(v0[0], v0[1]); w.y = cvt_pk_bf16(v0[2], v0[3]); w.z = cvt_pk_bf16(v1[0], v1[1]); w.w = cvt_pk_bf16(v1[2], v1[3]);
                    *(u32x4*)(rowp + bj * HALF) = w; } }
    }
};
struct EpiRelu2 {
    static constexpr bool PERM = true, AFTER_DRAIN = false;
    bf16_t* O; int ldc;
    __device__ __forceinline__ void operator()(const f32x4 (&acc)[2][2][4][2], const Unit& u, int wr, int wc, int fr, int fq) const {
#pragma unroll
        for (int ai = 0; ai < 2; ++ai)
#pragma unroll
            for (int m = 0; m < 4; ++m) { bf16_t* rowp = O + (size_t)(u.pm * BM + ai * HALF + wr * 64 + m * 16 + fr) * ldc + u.pn * BM + wc * 32 + 8 * fq;
#pragma unroll
                for (int bj = 0; bj < 2; ++bj) { f32x4 v0 = acc[ai][bj][m][0], v1 = acc[ai][bj][m][1];
#pragma unroll
                    for (int j = 0; j < 4; ++j) { const float a = fmaxf(v0[j], 0.f), b = fmaxf(v1[j], 0.f); v0[j] = a * a; v1[j] = b * b; }
                    u32x4 w; w.x = cvt_pk_bf16(v0[0], v0[1]); w.y = cvt_pk_bf16(v0[2], v0[3]); w.z = cvt_pk_bf16(v1[0], v1[1]); w.w = cvt_pk_bf16(v1[2], v1[3]);
                    *(u32x4*)(rowp + bj * HALF) = w; } }
    }
};
}

namespace att {
constexpr int D = 128, LD = 1024;
constexpr float SCALE = 0.08838834764831845f;
constexpr float THR = 8.f;
constexpr bool WSKIP = false;
constexpr int NW = 8, QBLK = 32, KVBLK = 64, QB = NW * QBLK;
constexpr int SHM_V = KVBLK * D * 2, SHM_K = KVBLK * D * 2;
constexpr int ATT_LDS = 2 * SHM_V + 2 * SHM_K + NW * 64 * 4;
constexpr int FT_OFF = 73728;
using bf16 = __hip_bfloat16;
typedef short bf16x8 __attribute__((ext_vector_type(8)));
typedef short s16x4 __attribute__((ext_vector_type(4)));
typedef float f32x16 __attribute__((ext_vector_type(16)));
typedef float f32x4 __attribute__((ext_vector_type(4)));
typedef unsigned u32x4 __attribute__((ext_vector_type(4)));
template <class A, class Bt> struct same_t { static constexpr bool v = false; };
template <class A> struct same_t<A, A> { static constexpr bool v = true; };

#define KSWZ(row, colB) ((row) * 256 + ((colB) ^ (((row) & 7) << 4)))
#define SBAR() __builtin_amdgcn_sched_barrier(0)
__device__ __forceinline__ int v_st(int k, int c) { const int kk = (k & ~0xC) | ((k & 4) << 1) | ((k & 8) >> 1); return ((kk >> 3) * 4 + (c >> 5)) * 512 + ((kk & 7) * 32 + (c & 31)) * 2; }
__device__ __forceinline__ int v_rd_base(int lane) { return ((lane & 3) << 3) | (((lane >> 2) & 3) << 6) | (((lane >> 4) & 1) << 5) | (((lane >> 5) & 1) << 8); }
constexpr int v_rd_off(int d0, int ks, int half) { return d0 * 512 + ks * 4096 + half * 2048; }
__device__ __forceinline__ int crow(int r, int hi) { return (r & 3) + 8 * (r >> 2) + 4 * hi; }
__device__ __forceinline__ unsigned cvtpk(float lo, float hi) {
    unsigned r; asm volatile("v_cvt_pk_bf16_f32 %0, %1, %2" : "=v"(r) : "v"(lo), "v"(hi)); return r;
}
__device__ __forceinline__ bf16x8 pack8(f32x4 a, f32x4 b) {
    u32x4 w = {cvtpk(a[0], a[1]), cvtpk(a[2], a[3]), cvtpk(b[0], b[1]), cvtpk(b[2], b[3])};
    return *reinterpret_cast<bf16x8*>(&w);
}
template <class T> __device__ __forceinline__ bf16x8 load8(const T* p) {
    if constexpr (same_t<T, float>::v) { return pack8(*(const f32x4*)p, *(const f32x4*)(p + 4)); }
    else { return *reinterpret_cast<const bf16x8*>(p); }
}
__device__ __forceinline__ void mask_tile(f32x16& p0, f32x16& p1, int dq, unsigned W) {
    const float NEG = -__builtin_inff();
#pragma unroll
    for (int r = 0; r < 16; ++r) {
        const int c = (r & 3) + 8 * (r >> 2);
        if ((unsigned)(dq - c) >= W) p0[r] = NEG;
        if ((unsigned)(dq - c - 32) >= W) p1[r] = NEG;
    }
}
__device__ __forceinline__ void partialSM(f32x16& p0, f32x16& p1, float& m_reg, float& mn, float& alpha) {
    float pmax = p0[0]; for (int r = 1; r < 16; ++r) pmax = fmaxf(pmax, p0[r]); for (int r = 0; r < 16; ++r) pmax = fmaxf(pmax, p1[r]);
    { auto rr = __builtin_amdgcn_permlane32_swap(__float_as_uint(pmax), __float_as_uint(pmax), false, false);
      pmax = fmaxf(__uint_as_float(rr[0]), __uint_as_float(rr[1])); }
    constexpr float C2 = 1.4426950408889634f * SCALE;
    if (__builtin_expect(__all((pmax - m_reg) * SCALE <= THR), 1)) { mn = m_reg; alpha = 1.f; }
    else { mn = fmaxf(m_reg, pmax); alpha = __builtin_amdgcn_exp2f((m_reg - mn) * C2); m_reg = mn; }
    const float mnL = -mn * C2;
    for (int r = 0; r < 16; ++r) p0[r] = fmaf(p0[r], C2, mnL); for (int r = 0; r < 16; ++r) p1[r] = fmaf(p1[r], C2, mnL);
    for (int r = 0; r < 16; ++r) p0[r] = __builtin_amdgcn_exp2f(p0[r]);
}
__device__ __forceinline__ void finishSM(f32x16& p0, f32x16& p1, float alpha, float& l_reg, bf16x8& pa0, bf16x8& pa1, bf16x8& pa2, bf16x8& pa3) {
    for (int r = 0; r < 16; ++r) p1[r] = __builtin_amdgcn_exp2f(p1[r]);
    float ps = 0; for (int r = 0; r < 16; ++r) ps += p0[r]; for (int r = 0; r < 16; ++r) ps += p1[r];
    { auto rr = __builtin_amdgcn_permlane32_swap(__float_as_uint(ps), __float_as_uint(ps), false, false);
      ps = __uint_as_float(rr[0]) + __uint_as_float(rr[1]); }
    l_reg = l_reg * alpha + ps;
#define PK4(P, B_, OUT) do { unsigned a0 = cvtpk(P[B_+0], P[B_+1]), a1 = cvtpk(P[B_+2], P[B_+3]);                          \
        unsigned b0 = cvtpk(P[B_+4], P[B_+5]), b1 = cvtpk(P[B_+6], P[B_+7]);                                             \
        auto r0 = __builtin_amdgcn_permlane32_swap(a0, b0, false, false); auto r1 = __builtin_amdgcn_permlane32_swap(a1, b1, false, false); \
        u32x4 w = {r0[0], r1[0], r0[1], r1[1]}; OUT = *reinterpret_cast<bf16x8*>(&w); } while (0)
    PK4(p0, 0, pa0); PK4(p0, 8, pa1); PK4(p1, 0, pa2); PK4(p1, 8, pa3);
#undef PK4
}
template <int KB, bool SK>
__device__ __forceinline__ void qkt(f32x16& p0, f32x16& p1, const char* K_lds, int r32, int hi, const bf16x8* qr, bool act, const float* FTk) {
    if (SK && !act) { const float NEG = -__builtin_inff();
#pragma unroll
        for (int r = 0; r < 16; ++r) { p0[r] = NEG; p1[r] = NEG; } return; }
    { const f32x4* fb = (const f32x4*)FTk + hi;
#pragma unroll
      for (int i = 0; i < 4; ++i) { const f32x4 f0 = fb[2 * i], f1 = fb[8 + 2 * i];
#pragma unroll
        for (int j = 0; j < 4; ++j) { p0[4 * i + j] = f0[j]; p1[4 * i + j] = f1[j]; } } }
    const char* kb[4];
#pragma unroll
    for (int dd = 0; dd < 4; ++dd) kb[dd] = K_lds + KB * SHM_K + KSWZ(r32, (dd * 16 + hi * 8) * 2);
#pragma unroll
    for (int d0 = 0; d0 < 8; ++d0) { const char* a = kb[d0 & 3] + (d0 >> 2) * 128;
        bf16x8 b0 = *reinterpret_cast<const bf16x8*>(a);
        bf16x8 b1 = *reinterpret_cast<const bf16x8*>(a + 32 * 256);
        p0 = __builtin_amdgcn_mfma_f32_32x32x16_bf16(b0, qr[d0], p0, 0, 0, 0);
        p1 = __builtin_amdgcn_mfma_f32_32x32x16_bf16(b1, qr[d0], p1, 0, 0, 0); }
}
template <int VB, bool SK>
__device__ __forceinline__ void pv_tile(f32x16* o, int vb0, bf16x8 pa0, bf16x8 pa1, bf16x8 pa2, bf16x8 pa3, bool act) {
    if (SK && !act) return;
#define TRRD(dst, off) asm volatile("ds_read_b64_tr_b16 %0, %1 offset:%2" : "=&v"(dst) : "v"(vb0), "i"(off) : "memory")
#define PV_D0(d0) do { s16x4 l0, l1, l2, l3, h0, h1, h2, h3; constexpr int b_ = VB * SHM_V + v_rd_off(d0, 0, 0);     \
        TRRD(l0, b_); TRRD(h0, b_ + 2048); TRRD(l1, b_ + 4096); TRRD(h1, b_ + 6144); TRRD(l2, b_ + 8192); TRRD(h2, b_ + 10240); TRRD(l3, b_ + 12288); TRRD(h3, b_ + 14336); \
        asm volatile("s_waitcnt lgkmcnt(0)" ::: "memory"); SBAR();                 \
        o[d0] = __builtin_amdgcn_mfma_f32_32x32x16_bf16(pa0, (bf16x8){l0[0], l0[1], l0[2], l0[3], h0[0], h0[1], h0[2], h0[3]}, o[d0], 0, 0, 0);   \
        o[d0] = __builtin_amdgcn_mfma_f32_32x32x16_bf16(pa1, (bf16x8){l1[0], l1[1], l1[2], l1[3], h1[0], h1[1], h1[2], h1[3]}, o[d0], 0, 0, 0);   \
        o[d0] = __builtin_amdgcn_mfma_f32_32x32x16_bf16(pa2, (bf16x8){l2[0], l2[1], l2[2], l2[3], h2[0], h2[1], h2[2], h2[3]}, o[d0], 0, 0, 0);   \
        o[d0] = __builtin_amdgcn_mfma_f32_32x32x16_bf16(pa3, (bf16x8){l3[0], l3[1], l3[2], l3[3], h3[0], h3[1], h3[2], h3[3]}, o[d0], 0, 0, 0); } while (0)
    PV_D0(0); PV_D0(1); PV_D0(2); PV_D0(3);
#undef PV_D0
#undef TRRD
}

template <class TIn, class TOut> struct BlockRef { const TIn* Q; const TIn* K; const TIn* V; TOut* O; const float* F; int P0; int jlo; };
template <class TIn> struct Seam {
    bf16x8 qr[8];
    bf16x8 st_v0, st_v1, st_k0, st_k1; f32x4 sf0, sf1, sf2, sf3;
    f32x4 tq[16];
};
__device__ __forceinline__ int swa_jlo(int P0, int W) { const int lowk = P0 - W + 1; return lowk > 0 ? lowk / KVBLK : 0; }
#define ROW(p, k0, rr) ((p) + (size_t)(k0) * LD + (unsigned)((rr) * LD + sc))
#define VMW() asm volatile("s_waitcnt vmcnt(0)" ::: "memory")
#define VMWN(n) asm volatile("s_waitcnt vmcnt(%0)" :: "i"(n) : "memory")
#define SLOAD_H(Kp, Vp, Fp, k0) do { S.st_v0 = load8<TIn>(ROW(Vp, k0, sr)); S.st_v1 = load8<TIn>(ROW(Vp, k0, 32 + sr));              \
                         S.st_k0 = load8<TIn>(ROW(Kp, k0, sr)); S.st_k1 = load8<TIn>(ROW(Kp, k0, 32 + sr)); } while (0)
#define SWRITE_HK(bf) do { *(bf16x8*)(K_lds + (bf) * SHM_K + kws) = S.st_k0; *(bf16x8*)(K_lds + (bf) * SHM_K + kws + 32 * 256) = S.st_k1; } while (0)
#define SWRITE_HV(bf) do { *(bf16x8*)(V_lds + (bf) * SHM_V + vst0) = S.st_v0; *(bf16x8*)(V_lds + (bf) * SHM_V + vst1) = S.st_v1; } while (0)
#define SWRITE_H(bf) do { SWRITE_HV(bf); SWRITE_HK(bf); } while (0)
#define SLOAD_F(p, k0) do { S.sf0 = *(const f32x4*)ROW(p, k0, sr); S.sf1 = *(const f32x4*)(ROW(p, k0, sr) + 4);                \
                            S.sf2 = *(const f32x4*)ROW(p, k0, 32 + sr); S.sf3 = *(const f32x4*)(ROW(p, k0, 32 + sr) + 4); } while (0)
#define SWRITE_KF(bf) do { *(bf16x8*)(K_lds + (bf) * SHM_K + kws) = pack8(S.sf0, S.sf1); *(bf16x8*)(K_lds + (bf) * SHM_K + kws + 32 * 256) = pack8(S.sf2, S.sf3); } while (0)
#define SWRITE_VF(bf) do { *(bf16x8*)(V_lds + (bf) * SHM_V + vst0) = pack8(S.sf0, S.sf1); *(bf16x8*)(V_lds + (bf) * SHM_V + vst1) = pack8(S.sf2, S.sf3); } while (0)
template <class TIn, class TOut>
__device__ __forceinline__ void causal_swa_prime(const BlockRef<TIn, TOut>& cur, int W, char* lds, Seam<TIn>& S) {
    constexpr bool F32 = same_t<TIn, float>::v;
    const int tid = threadIdx.x, wid = __builtin_amdgcn_readfirstlane(tid >> 6), lane = tid & 63, r32 = lane & 31, hi = lane >> 5;
    const int sr = tid >> 4, sc = (tid & 15) * 8, kws = KSWZ(sr, sc * 2); char* K_lds = lds + 2 * SHM_V;
    const int kb0 = cur.jlo * KVBLK;
    for (int d0 = 0; d0 < 8; ++d0) S.qr[d0] = load8<TIn>(cur.Q + (size_t)(wid * QBLK + r32) * LD + d0 * 16 + hi * 8);
    if constexpr (F32) { SLOAD_F((const float*)cur.K, kb0); VMW(); SWRITE_KF(0); SBAR(); SLOAD_F((const float*)cur.V, kb0); }
    else { SLOAD_H(cur.K, cur.V, cur.F, kb0); VMW(); SWRITE_HK(0); }
    __syncthreads();
}
template <class TIn, class TOut>
__device__ __forceinline__ void causal_swa_block(const BlockRef<TIn, TOut>& cur, const BlockRef<TIn, TOut>& nxt, int skv, int W, char* lds, Seam<TIn>& S) {
    constexpr bool F32 = same_t<TIn, float>::v;
    const int tid = threadIdx.x, wid = __builtin_amdgcn_readfirstlane(tid >> 6), lane = tid & 63, r32 = lane & 31, hi = lane >> 5;
    const int j_lo = cur.jlo;
    int j_hi = (cur.P0 + QB - 1) / KVBLK + 1; if (j_hi > skv / KVBLK) j_hi = skv / KVBLK;
    const int NT = j_hi - j_lo;
    const int kbn = nxt.jlo * KVBLK;
    const int qlo = cur.P0 + wid * QBLK, qm = qlo + r32 - 4 * hi;
    char* V_lds = lds; char* K_lds = lds + 2 * SHM_V;
    float* ws = (float*)(lds + 2 * SHM_V + 2 * SHM_K) + wid * 64; float* li_l = ws, * al_l = ws + 32; const float* FT = (const float*)(lds + FT_OFF);
    const float* Fh = cur.F;
    float m_reg = -1e30f, l_reg = 0; f32x16 o[4] = {};
    const int sr = tid >> 4, sc = (tid & 15) * 8, vst0 = v_st(sr, sc), vst1 = v_st(32 + sr, sc), kws = KSWZ(sr, sc * 2);
    const int vb0 = (int)(uintptr_t)V_lds + v_rd_base(lane);
    const TIn* Kh = cur.K; const TIn* Vh = cur.V;
#define RESC(a) do { if (__any((a) < 1.f)) { if (hi == 0) al_l[r32] = (a); asm volatile("s_waitcnt lgkmcnt(0)" ::: "memory");              \
                     for (int d_ = 0; d_ < 4; ++d_) for (int r = 0; r < 16; ++r) o[d_][r] *= al_l[crow(r, hi)]; } } while (0)
#define KBASE(t) ((j_lo + (t)) * KVBLK)
#define ACT(t) (KBASE(t) <= qlo + QBLK - 1 && KBASE(t) + KVBLK - 1 >= qlo - W + 1)
#define MASKT(P0_, P1_, t) do { const int kb_ = KBASE(t); if ((!SK || ACT(t)) && (kb_ + KVBLK - 1 > qlo || kb_ <= qlo + QBLK - 1 - W)) mask_tile(P0_, P1_, qm - kb_, (unsigned)W); } while (0)
    constexpr int NQL = F32 ? 16 : 8;
    constexpr bool SK = WSKIP && !F32;
#define SEAM_K0() do { VMWN(NQL); if constexpr (F32) { SWRITE_KF(0); SBAR(); SLOAD_F((const float*)nxt.V, kbn); } else { SWRITE_HK(0); } SBAR(); } while (0)
    f32x16 pA0, pA1, pB0, pB1; float mnA, mnB, alA, alB; bf16x8 pa0, pa1, pa2, pa3;
    if constexpr (F32) { VMW(); SWRITE_VF(0); SBAR(); } else { SWRITE_HV(0); SBAR(); }
    if (NT > 1) { if constexpr (F32) SLOAD_F((const float*)Kh, KBASE(1)); else SLOAD_H(Kh, Vh, Fh, KBASE(1)); }
    SBAR(); qkt<0, SK>(pA0, pA1, K_lds, r32, hi, S.qr, ACT(0), FT + KBASE(0));
    if constexpr (F32) { if (NT > 1) { VMW(); SWRITE_KF(1); SBAR(); SLOAD_F((const float*)Vh, KBASE(1)); } }
    MASKT(pA0, pA1, 0); partialSM(pA0, pA1, m_reg, mnA, alA);
    if (NT > 1) { VMW(); if constexpr (F32) { SWRITE_VF(1); SBAR(); if (NT > 2) SLOAD_F((const float*)Kh, KBASE(2)); } else SWRITE_H(1); }
    __syncthreads();
#define HALF_STEP(PX0, PX1, mnX, alX, PY0, PY1, alY, t, KB, VB, SB) do {                                                      \
        SBAR(); qkt<KB, SK>(PX0, PX1, K_lds, r32, hi, S.qr, ACT(t), FT + KBASE(t));                                             \
        finishSM(PY0, PY1, alY, l_reg, pa0, pa1, pa2, pa3); SBAR();                                                           \
        if ((t) + 1 < NT) { if constexpr (F32) { VMW(); SWRITE_KF(SB); SBAR(); SLOAD_F((const float*)Vh, KBASE((t) + 1)); }  \
                            else { SLOAD_H(Kh, Vh, Fh, KBASE((t) + 1)); } SBAR(); }                                               \
        pv_tile<VB, SK>(o, vb0, pa0, pa1, pa2, pa3, ACT((t) - 1)); MASKT(PX0, PX1, (t)); partialSM(PX0, PX1, m_reg, mnX, alX);                                        \
        __syncthreads();                                                                                                      \
        if ((t) + 1 < NT) { VMW(); if constexpr (F32) { SWRITE_VF(SB); SBAR(); if ((t) + 2 < NT) SLOAD_F((const float*)Kh, KBASE((t) + 2)); } \
                            else { SWRITE_H(SB); } }                                                                          \
        RESC(alX); __syncthreads(); } while (0)
    for (int t = 1; t + 1 < NT; t += 2) {
        HALF_STEP(pB0, pB1, mnB, alB, pA0, pA1, alA, t, 1, 0, 0);
        HALF_STEP(pA0, pA1, mnA, alA, pB0, pB1, alB, t + 1, 0, 1, 1);
    }
    const bool even = (NT & 1) == 0;
    if (even) { SBAR(); qkt<1, SK>(pB0, pB1, K_lds, r32, hi, S.qr, ACT(NT - 1), FT + KBASE(NT - 1)); SBAR(); }
#define QROW(e) (nxt.Q + (size_t)(wid * QBLK + r32) * LD + ((e) >> 1) * 16 + hi * 8 + ((e) & 1) * 4)
    if constexpr (F32) { SLOAD_F((const float*)nxt.K, kbn); SBAR();
#pragma unroll
        for (int e = 0; e < 8; ++e) S.tq[e] = *(const f32x4*)QROW(e); }
    else { SLOAD_H(nxt.K, nxt.V, nxt.F, kbn); SBAR();
#pragma unroll
        for (int d0 = 0; d0 < 8; ++d0) S.qr[d0] = load8<TIn>(nxt.Q + (size_t)(wid * QBLK + r32) * LD + d0 * 16 + hi * 8); }
    SBAR();
    finishSM(pA0, pA1, alA, l_reg, pa0, pa1, pa2, pa3); SBAR();
    if constexpr (F32) {
#pragma unroll
        for (int e = 8; e < 16; ++e) S.tq[e] = *(const f32x4*)QROW(e); SBAR(); }
#undef QROW
    pv_tile<0, SK>(o, vb0, pa0, pa1, pa2, pa3, ACT(even ? NT - 2 : NT - 1));
    if (even) { MASKT(pB0, pB1, NT - 1); partialSM(pB0, pB1, m_reg, mnB, alB); __syncthreads(); RESC(alB);
        finishSM(pB0, pB1, alB, l_reg, pa0, pa1, pa2, pa3); SBAR(); pv_tile<1, SK>(o, vb0, pa0, pa1, pa2, pa3, ACT(NT - 1)); }
    SBAR(); SEAM_K0();
    if (hi == 0) li_l[r32] = l_reg; asm volatile("s_waitcnt lgkmcnt(0)" ::: "memory");
    float rli[16];
#pragma unroll
    for (int r = 0; r < 16; ++r) rli[r] = __builtin_amdgcn_rcpf(li_l[crow(r, hi)]);
    TOut* Ow = cur.O + (size_t)(wid * QBLK) * LD;
#pragma unroll
    for (int r = 0; r < 16; ++r) { const int orow = crow(r, hi);
#pragma unroll
        for (int d0 = 0; d0 < 4; ++d0) { const float v = o[d0][r] * rli[r];
            if constexpr (same_t<TOut, float>::v) { Ow[(size_t)orow * LD + d0 * 32 + r32] = v; }
            else { const float vn = __shfl_xor(v, 1);
                   if ((r32 & 1) == 0) *(unsigned*)(Ow + (size_t)orow * LD + d0 * 32 + r32) = cvtpk(v, vn); } } }
    if constexpr (F32) {
#pragma unroll
        for (int d0 = 0; d0 < 8; ++d0) S.qr[d0] = pack8(S.tq[2 * d0], S.tq[2 * d0 + 1]); }
    __syncthreads();
#undef RESC
#undef KBASE
#undef ACT
#undef MASKT
#undef SEAM_K0
#undef HALF_STEP
}
#undef ROW
#undef VMW
#undef VMWN
#undef SLOAD_H
#undef SWRITE_HK
#undef SWRITE_HV
#undef SWRITE_H
#undef SLOAD_F
#undef SWRITE_KF
#undef SWRITE_VF
}

#define XB_TMO      128
#define XB_XCNT(j)  (256  + 64 * (j))
#define XB_XSUB(j)  (1280 + 64 * (j))
#define XB_XGEN(j)  (2304 + 64 * (j))
#define XB_TOP      3328
#define XB_TOPGEN   3392
#define XCD_BAR_WORDS 3456
#define XB_SPIN_CAP (1u << 18)

__device__ __forceinline__ unsigned xb_ld(unsigned* p)              { return __hip_atomic_load(p, __ATOMIC_RELAXED, __HIP_MEMORY_SCOPE_AGENT); }
__device__ __forceinline__ unsigned xb_add(unsigned* p, unsigned v) { return __hip_atomic_fetch_add(p, v, __ATOMIC_RELAXED, __HIP_MEMORY_SCOPE_AGENT); }
__device__ __forceinline__ unsigned xb_xcc_id() { return (unsigned)__builtin_amdgcn_s_getreg((3 << 11) | 20) & 0xFu; }
#define XB_SPIN(cond, bar) do { unsigned _sp = 0; while (cond) { __builtin_amdgcn_s_sleep(1); \
    if ((++_sp & 255u) == 0u) { if (xb_ld(&(bar)[XB_TMO])) break; if (_sp > XB_SPIN_CAP) { atomicAdd(&(bar)[XB_TMO], 1u); break; } } } } while (0)

struct XcdBarrier {
    unsigned* bar; unsigned x;
    volatile LAS unsigned* st;
};

__device__ __forceinline__ XcdBarrier xcd_barrier_post(unsigned* bar, volatile LAS unsigned* st) {
    XcdBarrier b; b.bar = bar; b.x = xb_xcc_id(); b.st = st;
    if (threadIdx.x == 0) (void)xb_add(&bar[XB_XCNT(b.x)], 1u);
    return b;
}
__device__ __forceinline__ void xcd_barrier_complete(unsigned* bar, unsigned x, unsigned& nloc, unsigned& nx) {
    const unsigned G = gridDim.x * gridDim.y * gridDim.z;
    unsigned sum, cnt, mine, sp = 0u;
    for (;;) {
        sum = 0u; cnt = 0u; mine = 0u;
#pragma unroll
        for (unsigned j = 0; j < 16; ++j) { const unsigned c = xb_ld(&bar[XB_XCNT(j)]); sum += c; cnt += (c > 0u) ? 1u : 0u; mine = (j == x) ? c : mine; }
        if (sum == G) break;
        __builtin_amdgcn_s_sleep(1);
        if ((++sp & 255u) == 0u) { if (xb_ld(&bar[XB_TMO])) break; if (sp > XB_SPIN_CAP) { atomicAdd(&bar[XB_TMO], 1u); break; } }
    }
    nloc = mine > 0u ? mine : 1u; nx = cnt > 0u ? cnt : 1u;
}

__device__ __forceinline__ void xcd_barrier(const XcdBarrier& b) {
    asm volatile("s_waitcnt vmcnt(0)" ::: "memory");
    __syncthreads();
    if (threadIdx.x == 0) {
        unsigned* bar = b.bar;
        __builtin_amdgcn_s_waitcnt(0);
        unsigned nloc = b.st[0], nx = b.st[1];
        if (nloc == 0u) { xcd_barrier_complete(bar, b.x, nloc, nx); b.st[0] = nloc; b.st[1] = nx; }
        const unsigned old = xb_add(&bar[XB_XSUB(b.x)], 1u);
        const unsigned gen = old / nloc;
        if (old + 1u == (gen + 1u) * nloc) {
            __builtin_amdgcn_fence(__ATOMIC_RELEASE, "agent");
            asm volatile("s_waitcnt vmcnt(0)" ::: "memory");
            const unsigned og = xb_add(&bar[XB_TOP], 1u);
            const unsigned tg = og / nx;
            if (og + 1u == (tg + 1u) * nx) xb_add(&bar[XB_TOPGEN], 1u);
            else XB_SPIN(xb_ld(&bar[XB_TOPGEN]) == tg, bar);
            __builtin_amdgcn_fence(__ATOMIC_ACQUIRE, "agent");
            xb_add(&bar[XB_XGEN(b.x)], 1u);
            asm volatile("s_waitcnt vmcnt(0)" ::: "memory");
        } else {
            XB_SPIN(xb_ld(&bar[XB_XGEN(b.x)]) == gen, bar);
            __builtin_amdgcn_fence(__ATOMIC_ACQUIRE, "agent");
            asm volatile("s_waitcnt vmcnt(0)" ::: "memory");
        }
    }
    __syncthreads();
}

typedef float f32x2_t __attribute__((ext_vector_type(2))); typedef __bf16 bf16x2_t __attribute__((ext_vector_type(2)));
__device__ __forceinline__ unsigned cvtpk_c(float lo, float hi) { f32x2_t v = {lo, hi}; bf16x2_t b = __builtin_convertvector(v, bf16x2_t); return __builtin_bit_cast(unsigned, b); }

#define WSP(T, off) ((T*)(pq->ws + (off)))
__device__ __forceinline__ unsigned short f2bf1(float v) { return (unsigned short)(pk2(v, 0.f) & 0xffffu); }

__device__ __forceinline__ int in_srccol(int n) {
    if (n < 3072) return n;
    if (n < 6144) return n + 8;
    if (n < 8192) return n + 24;
    if (n < 8200) return 3072 + (n - 8192);
    if (n < 8216) return 6152 + (n - 8200);
    return -1;
}
template <bool MAPIN>
__device__ __forceinline__ void transpose_item(const float* __restrict__ W, int K, int Nsrc, int Ndst, bf16_t* __restrict__ WT, LAS float* scr, int item, int lane) {
    const int nblk = Ndst / 32, kb = item / nblk, nb = item % nblk, k0 = 64 * kb, n0 = 32 * nb;
    const int n = n0 + (lane & 31); const int sc = MAPIN ? in_srccol(n) : n;
#pragma unroll 16
    for (int i = 0; i < 32; ++i) { const int kk = 2 * i + (lane >> 5); scr[kk * 33 + (lane & 31)] = sc >= 0 ? W[(size_t)(k0 + kk) * Nsrc + sc] : 0.f; }
    const int c = lane & 7;
#pragma unroll
    for (int j = 0; j < 4; ++j) { const int n_ = (lane >> 3) + 8 * j; const LAS float* s = scr + (8 * c) * 33 + n_;
        u32x4 o; o.x = pk2(s[0 * 33], s[1 * 33]); o.y = pk2(s[2 * 33], s[3 * 33]); o.z = pk2(s[4 * 33], s[5 * 33]); o.w = pk2(s[6 * 33], s[7 * 33]);
        *(u32x4*)(WT + (size_t)(n0 + n_) * K + k0 + 8 * c) = o; }
}
__device__ __forceinline__ void phase0(PP pq, LAS unsigned char* lds, int tid, int lane, int wave) {
    if (blockIdx.x == 0 && tid < 32) WSP(unsigned, WS_NRM)[tid] = 0u;
    {
        LAS float* SC = (LAS float*)lds; LAS float* PR = (LAS float*)(lds + 17 * 1024 * 4);
        const float* cp = pq->in[I_CP]; const float* cs = pq->in[I_CS];
        for (int i = tid; i < 17 * 1024; i += NTHR) { const int r = i >> 10, k = i & 1023; const float c = r == 0 ? cp[k] : cs[(r - 1) * 1024 + k]; SC[i] = siluf_(c); }
        __syncthreads();
        const float* wada = pq->in[I_WADA]; const float* bada = pq->in[I_BADA]; float* mod = WSP(float, WS_MOD);
        for (int cb = blockIdx.x; cb < 256; cb += gridDim.x) {
            const int kq = tid >> 3, cq = tid & 7, col = cb * 24 + cq * 3;
            float acc[17][3];
#pragma unroll
            for (int r = 0; r < 17; ++r) { acc[r][0] = 0.f; acc[r][1] = 0.f; acc[r][2] = 0.f; }
#pragma unroll 4
            for (int kk = 0; kk < 16; ++kk) { const int k = kq + 64 * kk; const float* wr = wada + (size_t)k * 6144 + col; const float w0 = wr[0], w1 = wr[1], w2 = wr[2];
#pragma unroll
                for (int r = 0; r < 17; ++r) { const float s = SC[r * 1024 + k]; acc[r][0] += s * w0; acc[r][1] += s * w1; acc[r][2] += s * w2; } }
#pragma unroll
            for (int r = 0; r < 17; ++r)
#pragma unroll
                for (int j = 0; j < 3; ++j) { float a = acc[r][j]; a += __shfl_xor(a, 8); a += __shfl_xor(a, 16); a += __shfl_xor(a, 32); acc[r][j] = a; }
            if ((lane >> 3) == 0) {
#pragma unroll
                for (int r = 0; r < 17; ++r)
#pragma unroll
                    for (int j = 0; j < 3; ++j) PR[wave * 408 + r * 24 + cq * 3 + j] = acc[r][j];
            }
            __syncthreads();
            if (tid < 408) { const int r = tid / 24, cc = tid % 24; float s = 0.f;
#pragma unroll
                for (int w = 0; w < 8; ++w) s += PR[w * 408 + tid];
                mod[r * 6144 + cb * 24 + cc] = s + bada[cb * 24 + cc]; }
            __syncthreads();
        }
    }
    {
        LAS float* scr = (LAS float*)(lds + wave * 16384);
        const int gw = blockIdx.x * NWV + wave, ngw = gridDim.x * NWV;
        constexpr int I_IN = (DM / 64) * (NIN / 32);
        (void)scr; (void)gw; (void)ngw; (void)I_IN;
        { LAS float* T = (LAS float*)lds; const float* W = pq->in[I_WIN]; bf16_t* WT = WSP(bf16_t, WS_WTIN);
          const int kk = tid >> 5, c8 = (tid & 31) * 8, nn = tid >> 1, kh = (tid & 1) * 8;
          f32x4 pa = (f32x4){0.f, 0.f, 0.f, 0.f}, pb = pa;
          { const int it0 = blockIdx.x; if (it0 < 64 * 33) { const int kb = it0 / 33, nb = it0 - kb * 33; if (nb < 32) { const float* src = W + (size_t)(16 * kb + kk) * 8216 + in_srccol(256 * nb) + c8; pa = *(const f32x4*)src; pb = *(const f32x4*)(src + 4); } } }
          for (int it = blockIdx.x; it < 64 * 33; it += gridDim.x) { const int kb = it / 33, nb = it - kb * 33, k0 = 16 * kb, n0 = 256 * nb;
              __syncthreads();
              if (nb < 32) { *(LAS f32x4*)(T + kk * 260 + c8) = pa; *(LAS f32x4*)(T + kk * 260 + c8 + 4) = pb;
                  }
              else {
#pragma unroll
                  for (int e = 0; e < 8; ++e) { const int sc = in_srccol(n0 + c8 + e); T[kk * 260 + c8 + e] = sc >= 0 ? W[(size_t)(k0 + kk) * 8216 + sc] : 0.f; } }
              { const int itn = it + gridDim.x; if (itn < 64 * 33) { const int kbn = itn / 33, nbn = itn - kbn * 33; if (nbn < 32) { const float* src = W + (size_t)(16 * kbn + kk) * 8216 + in_srccol(256 * nbn) + c8; pa = *(const f32x4*)src; pb = *(const f32x4*)(src + 4); } } }
              __syncthreads();
              u32x4 o; o.x = pk2(T[(kh + 0) * 260 + nn], T[(kh + 1) * 260 + nn]); o.y = pk2(T[(kh + 2) * 260 + nn], T[(kh + 3) * 260 + nn]);
              o.z = pk2(T[(kh + 4) * 260 + nn], T[(kh + 5) * 260 + nn]); o.w = pk2(T[(kh + 6) * 260 + nn], T[(kh + 7) * 260 + nn]);
              *(u32x4*)(WT + (size_t)(n0 + nn) * DM + k0 + kh) = o; }
          __syncthreads(); }
    }
}
__device__ __forceinline__ void block_transpose(const float* __restrict__ W, int K, int N, bf16_t* __restrict__ WT, LAS unsigned char* lds, int tid, int first, int nw) {
    LAS float* T = (LAS float*)lds; const int nnb = N / 256, nitems = (K / 16) * nnb;
    const int kk = tid >> 5, c8 = (tid & 31) * 8, nn = tid >> 1, kh = (tid & 1) * 8;
    for (int it = first; it < nitems; it += nw) { const int kb = it / nnb, nb = it - kb * nnb, k0 = 16 * kb, n0 = 256 * nb;
        __syncthreads();
        { const float* src = W + (size_t)(k0 + kk) * N + n0 + c8; const f32x4 a = *(const f32x4*)src, b = *(const f32x4*)(src + 4); *(LAS f32x4*)(T + kk * 260 + c8) = a; *(LAS f32x4*)(T + kk * 260 + c8 + 4) = b; }
        __syncthreads();
        u32x4 o; o.x = pk2(T[(kh + 0) * 260 + nn], T[(kh + 1) * 260 + nn]); o.y = pk2(T[(kh + 2) * 260 + nn], T[(kh + 3) * 260 + nn]);
        o.z = pk2(T[(kh + 4) * 260 + nn], T[(kh + 5) * 260 + nn]); o.w = pk2(T[(kh + 6) * 260 + nn], T[(kh + 7) * 260 + nn]);
        *(u32x4*)(WT + (size_t)(n0 + nn) * K + k0 + kh) = o; }
    __syncthreads();
}
__device__ __forceinline__ void late_transposes(PP pq, LAS unsigned char* lds, int tid, int first, int nw) {
    block_transpose(pq->in[I_WOUT], DM, DM, WSP(bf16_t, WS_WTOUT), lds, tid, first, nw);
    block_transpose(pq->in[I_WUP], DM, DFF, WSP(bf16_t, WS_WTUP), lds, tid, first, nw);
    block_transpose(pq->in[I_WDN], DFF, DM, WSP(bf16_t, WS_WTDN), lds, tid, first, nw);
}

__device__ __forceinline__ const float* xrow_ptr(PP pq, int row) { return row < SEQ ? pq->in[I_XP] + (size_t)row * DM : pq->in[I_XS] + (size_t)(row - SEQ) * DM; }
__device__ __forceinline__ float* yrow_ptr(PP pq, int row) { return row < SEQ ? pq->out + O_YP + (size_t)row * DM : pq->out + O_YS + (size_t)(row - SEQ) * DM; }
__device__ __forceinline__ int modrow(int row) { return row < SEQ ? 0 : 1 + ((row - SEQ) >> 4); }
__device__ __forceinline__ float sumsq4(const f32x4 (&v)[4]) { float s = 0.f;
#pragma unroll
    for (int j = 0; j < 4; ++j) s += (v[j].x * v[j].x + v[j].y * v[j].y) + (v[j].z * v[j].z + v[j].w * v[j].w);
    return s; }
__device__ __forceinline__ void modnorm_store(const f32x4 (&v)[4], float rstd, const float* g, const float* sc, const float* sh, bf16_t* orow, int lane) {
#pragma unroll
    for (int j = 0; j < 4; ++j) { const int c = 4 * lane + 256 * j; const f32x4 gg = *(const f32x4*)(g + c), s1 = *(const f32x4*)(sc + c), s0 = *(const f32x4*)(sh + c);
        const f32x4 o = v[j] * rstd * gg * (s1 + 1.f) + s0; u32x2 w; w.x = pk2(o.x, o.y); w.y = pk2(o.z, o.w); *(u32x2*)(orow + c) = w; }
}
__device__ __forceinline__ void phase1(PP pq, int lane, int gw, int ngw) {
    const float* mod = WSP(float, WS_MOD); bf16_t* H = WSP(bf16_t, WS_H);
    for (int row = gw; row < R; row += 2 * ngw) {
        const int r1 = row + ngw; const bool has1 = r1 < R; const int rb = has1 ? r1 : row;
        const f32x4* xa = (const f32x4*)xrow_ptr(pq, row) + lane; const f32x4* xb = (const f32x4*)xrow_ptr(pq, rb) + lane; f32x4 va[4], vb[4];
#pragma unroll
        for (int j = 0; j < 4; ++j) { va[j] = xa[64 * j]; vb[j] = xb[64 * j]; }
        const float ra = 1.f / sqrtf(wave_sum(sumsq4(va)) * (1.f / DM) + EPS), rbs = 1.f / sqrtf(wave_sum(sumsq4(vb)) * (1.f / DM) + EPS);
        const float* ma = mod + (size_t)modrow(row) * 6144; const float* mb = mod + (size_t)modrow(rb) * 6144;
        modnorm_store(va, ra, pq->in[I_GPM], ma + 1024, ma, H + (size_t)row * DM, lane);
        if (has1) modnorm_store(vb, rbs, pq->in[I_GPM], mb + 1024, mb, H + (size_t)rb * DM, lane);
    }
}

__device__ __forceinline__ void unpack16(const bf16_t* ptr, float (&f)[16]) {
    const u32x4 a = *(const u32x4*)ptr, b = *(const u32x4*)(ptr + 8);
    f[0] = bflo(a.x); f[1] = bfhi(a.x); f[2] = bflo(a.y); f[3] = bfhi(a.y); f[4] = bflo(a.z); f[5] = bfhi(a.z); f[6] = bflo(a.w); f[7] = bfhi(a.w);
    f[8] = bflo(b.x); f[9] = bfhi(b.x); f[10] = bflo(b.y); f[11] = bfhi(b.y); f[12] = bflo(b.z); f[13] = bfhi(b.z); f[14] = bflo(b.w); f[15] = bfhi(b.w);
}
__device__ __forceinline__ float block_excl_scan(float v, LAS float* sm, int lane, int wave) {
    float inc = v;
#pragma unroll
    for (int o = 1; o < 64; o <<= 1) { const float t = __shfl_up(inc, o); if (lane >= o) inc += t; }
    __syncthreads();
    if (lane == 63) sm[wave] = inc;
    __syncthreads();
    float base = 0.f;
    for (int w = 0; w < wave; ++w) base += sm[w];
    return base + inc - v;
}
__device__ __forceinline__ void phase3(PP pq, LAS unsigned char* lds, int tid, int lane, int wave) {
    {
        const bf16_t* Qb = WSP(bf16_t, WS_Q); const bf16_t* Kb = WSP(bf16_t, WS_K); float mq = 0.f, mk = 0.f;
        for (int row0 = blockIdx.x * NWV + wave; row0 < SEQ; row0 += 2 * gridDim.x * NWV) {
            const int row1 = row0 + gridDim.x * NWV; const bool has1 = row1 < SEQ; const int rr[2] = {row0, has1 ? row1 : row0};
            float a[2][16], b[2][16];
#pragma unroll
            for (int t = 0; t < 2; ++t) { unpack16(Qb + (size_t)rr[t] * DM + 16 * lane, a[t]); unpack16(Kb + (size_t)rr[t] * DM + 16 * lane, b[t]); }
#pragma unroll
            for (int t = 0; t < 2; ++t) { float sa = 0.f, sb = 0.f, sd = 0.f;
#pragma unroll
                for (int e = 0; e < 16; ++e) { sa += a[t][e] * a[t][e]; sb += b[t][e] * b[t][e]; sd += a[t][e] * b[t][e]; }
                sa += __shfl_xor(sa, 1); sa += __shfl_xor(sa, 2); sa += __shfl_xor(sa, 4); sb += __shfl_xor(sb, 1); sb += __shfl_xor(sb, 2); sb += __shfl_xor(sb, 4);
                sd += __shfl_xor(sd, 1); sd += __shfl_xor(sd, 2); sd += __shfl_xor(sd, 4);
                if ((lane & 7) == 0 && (t == 0 || has1)) { WSP(float, WS_GQ)[(size_t)(lane >> 3) * SEQ + rr[t]] = sqrtf(sa); WSP(float, WS_GD)[(size_t)(lane >> 3) * SEQ + rr[t]] = sd * FOX_SCALE; }
                mq = fmaxf(mq, sa); mk = fmaxf(mk, sb); } }
        LAS float* red = (LAS float*)(lds + 4096);
        if ((lane & 7) == 0) { red[wave * 16 + (lane >> 3)] = mq; red[wave * 16 + 8 + (lane >> 3)] = mk; }
        __syncthreads();
        if (tid < 16) { float m = red[tid];
#pragma unroll
            for (int w = 1; w < 8; ++w) m = fmaxf(m, red[w * 16 + tid]);
            atomicMax(WSP(unsigned, WS_NRM) + tid, __float_as_uint(m)); }
        __syncthreads();
    }
    LAS float* sm = (LAS float*)lds; const float* LOGF = WSP(float, WS_LOGF);
    for (int u = blockIdx.x; u < 8 + 128; u += gridDim.x) {
        if (u < 8) { const int h = u, base = tid * 32; float loc = 0.f; const f32x4* lt4 = (const f32x4*)(WSP(float, WS_LOGFT) + (size_t)h * SEQ + base); f32x4 lv[8];
#pragma unroll
            for (int j = 0; j < 8; ++j) { lv[j] = lt4[j]; loc += (lv[j].x + lv[j].y) + (lv[j].z + lv[j].w); }
            float run = block_excl_scan(loc, sm, lane, wave); f32x4* FSP4 = (f32x4*)(WSP(float, WS_FSP) + (size_t)h * SEQ + base);
#pragma unroll
            for (int j = 0; j < 8; ++j) { f32x4 o; run += lv[j].x; o.x = run * INV_SCALE; run += lv[j].y; o.y = run * INV_SCALE; run += lv[j].z; o.z = run * INV_SCALE; run += lv[j].w; o.w = run * INV_SCALE; FSP4[j] = o; }
        } else { const int bh = u - 8, b = bh >> 3, h = bh & 7, base = tid * 3; float vals[3]; float loc = 0.f;
#pragma unroll
            for (int j = 0; j < 3; ++j) { const int s = base + j; float v = 0.f;
                if (s < TKS) v = s < PAST ? pq->in[I_CLF][((size_t)b * PAST + s) * 8 + h] : LOGF[(size_t)(SEQ + b * 16 + s - PAST) * 8 + h];
                vals[j] = v; loc += v; }
            float run = block_excl_scan(loc, sm, lane, wave); float* FSS = WSP(float, WS_FSS) + (size_t)bh * TKS;
#pragma unroll
            for (int j = 0; j < 3; ++j) { run += vals[j]; if (base + j < TKS) FSS[base + j] = run; }
        }
    }
}

typedef att::BlockRef<att::bf16, att::bf16> ABlk;
__device__ __forceinline__ ABlk attn_ref(PP pq, int idx) {
    const int L = blockIdx.x + (idx >> 1) * gridDim.x, head = L >> 5, x = L & 31, qb = (idx & 1) ? 63 - x : x, P0 = qb * 256;
    ABlk r; r.Q = WSP(att::bf16, WS_Q) + (size_t)P0 * DM + head * HD; r.K = WSP(att::bf16, WS_K) + head * HD; r.V = WSP(att::bf16, WS_V) + head * HD;
    r.O = WSP(att::bf16, WS_H) + (size_t)P0 * DM + head * HD; r.F = WSP(float, WS_FSP) + (size_t)head * SEQ; r.P0 = P0;
    { const unsigned* nrm = WSP(unsigned, WS_NRM); const float U = sqrtf(__uint_as_float(nrm[head]) * __uint_as_float(nrm[8 + head])) * FOX_SCALE;
      int ln = threadIdx.x & 63; asm volatile("" : "+v"(ln));
      const float kmaxs = sqrtf(__uint_as_float(nrm[8 + head])) * FOX_SCALE; const float* gq = WSP(float, WS_GQ) + (size_t)head * SEQ + P0; const float* gd = WSP(float, WS_GD) + (size_t)head * SEQ + P0;
      float gmin = fminf(fminf(gd[ln] - gq[ln] * kmaxs, gd[ln + 64] - gq[ln + 64] * kmaxs), fminf(gd[ln + 128] - gq[ln + 128] * kmaxs, gd[ln + 192] - gq[ln + 192] * kmaxs));
#pragma unroll
      for (int o = 1; o < 64; o <<= 1) gmin = fminf(gmin, __shfl_xor(gmin, o));
      const float thrS = (fmaxf(gmin, -2.f * U) - 32.f) * INV_SCALE, f0 = r.F[P0]; const int jd = P0 >> 6; int best = jd;
#pragma unroll
      for (int k = 0; k < 4; ++k) { const int j = ln + 64 * k; const bool ok = (j <= jd) && (f0 - r.F[64 * (j <= jd ? j : jd) + 63] >= thrS);
          const unsigned long long m = __ballot(ok); if (m) { const int first = __builtin_ctzll(m) + 64 * k; best = first < best ? first : best; } }
      r.jlo = __builtin_amdgcn_readfirstlane(best); }
    return r;
}
__device__ __forceinline__ void phase4(PP pq, char* lds) {
    if ((int)blockIdx.x >= 256) return;
    const int nmine = (256 - (int)blockIdx.x + (int)gridDim.x - 1) / (int)gridDim.x, nb = 2 * nmine;
    constexpr int W = 1 << 30;
    att::Seam<att::bf16> S;
    ABlk cur = attn_ref(pq, 0);
    att::causal_swa_prime<att::bf16, att::bf16>(cur, W, lds, S);
    float* FT = (float*)(lds + att::FT_OFF);
    for (int idx = 0; idx < nb; ++idx) {
        const ABlk nxt = (idx + 1 < nb) ? attn_ref(pq, idx + 1) : cur;
        { const float fref = cur.F[cur.P0];
            int t4_ = threadIdx.x * 4; asm volatile("" : "+v"(t4_));
            for (int s0 = cur.jlo * 64 + t4_; s0 < cur.P0 + 256; s0 += NTHR * 4) { const f32x4 f = *(const f32x4*)(cur.F + s0); *(f32x4*)(FT + s0) = (f32x4){fref - f.x, fref - f.y, fref - f.z, fref - f.w}; }
            __syncthreads(); }
        att::causal_swa_block<att::bf16, att::bf16>(cur, nxt, SEQ, W, lds, S);
        cur = nxt;
    }
}

__device__ __forceinline__ void sample_attn(PP pq, LAS unsigned char* lds, int tid, int b, int h) {
    LAS float* S = (LAS float*)lds; LAS float* Ql = S + 16 * TKS; LAS float* Fl = Ql + 16 * 128; LAS float* inv = Fl + TKS;
    bf16_t* Qb = WSP(bf16_t, WS_Q); const bf16_t* Kb = WSP(bf16_t, WS_K); const bf16_t* Vb = WSP(bf16_t, WS_V);
    const float* FSS = WSP(float, WS_FSS) + (size_t)(b * 8 + h) * TKS;
    __syncthreads();
#pragma unroll 1
    for (int idx = tid; idx < 2048; idx += NTHR) { const int i = idx >> 7, d = idx & 127; Ql[idx] = bf2f(Qb[(size_t)(SEQ + b * 16 + i) * DM + h * HD + d]); }
#pragma unroll 1
    for (int idx = tid; idx < TKS; idx += NTHR) Fl[idx] = FSS[idx];
    __syncthreads();
    {
        const int lane_ = tid & 63, wave_ = tid >> 6, fr = lane_ & 15, fq = lane_ >> 4;
        bf16x8 qf[4];
#pragma unroll
        for (int ks = 0; ks < 4; ++ks) qf[ks] = *(const bf16x8*)(Qb + (size_t)(SEQ + b * 16 + fr) * DM + h * HD + 32 * ks + 8 * fq);
#pragma unroll 3
        for (int kt = wave_; kt < 65; kt += 8) {
            bf16x8 kf[4];
            if (kt < 64) { const float* kr = pq->in[I_CK] + ((size_t)(b * PAST + kt * 16 + fr) * NH + h) * HD + 8 * fq;
#pragma unroll
                for (int ks = 0; ks < 4; ++ks) { const f32x4 a = __builtin_nontemporal_load((const f32x4*)(kr + 32 * ks)), c = __builtin_nontemporal_load((const f32x4*)(kr + 32 * ks + 4));
                    const u32x4 w = (u32x4){cvtpk_c(a.x, a.y), cvtpk_c(a.z, a.w), cvtpk_c(c.x, c.y), cvtpk_c(c.z, c.w)}; kf[ks] = __builtin_bit_cast(bf16x8, w); } }
            else { const bf16_t* kr = Kb + (size_t)(SEQ + b * 16 + fr) * DM + h * HD + 8 * fq;
#pragma unroll
                for (int ks = 0; ks < 4; ++ks) kf[ks] = *(const bf16x8*)(kr + 32 * ks); }
            f32x4 acc = (f32x4){0.f, 0.f, 0.f, 0.f};
#pragma unroll
            for (int ks = 0; ks < 4; ++ks) acc = __builtin_amdgcn_mfma_f32_16x16x32_bf16(qf[ks], kf[ks], acc, 0, 0, 0);
            const int s = kt * 16 + fr; const float fs = Fl[s];
#pragma unroll
            for (int j = 0; j < 4; ++j) { const int i = 4 * fq + j; float v = acc[j] * FOX_SCALE + Fl[PAST + i] - fs; if (s > PAST + i) v = -__builtin_inff(); S[i * TKS + s] = v; }
        }
    }
    __syncthreads();
    { const int i = tid >> 5, l32 = tid & 31; float mx = -__builtin_inff();
#pragma unroll 1
        for (int s = l32; s < TKS; s += 32) mx = fmaxf(mx, S[i * TKS + s]);
#pragma unroll
        for (int o = 1; o < 32; o <<= 1) mx = fmaxf(mx, __shfl_xor(mx, o));
        float sum = 0.f;
#pragma unroll 1
        for (int s = l32; s < TKS; s += 32) { const float e = __expf(S[i * TKS + s] - mx); S[i * TKS + s] = e; sum += e; }
#pragma unroll
        for (int o = 1; o < 32; o <<= 1) sum += __shfl_xor(sum, o);
        if (l32 == 0) inv[i] = 1.f / sum; }
    __syncthreads();
    {
        const int d4 = (tid & 31) * 4, kg = tid >> 5; f32x4 o[16];
#pragma unroll
        for (int i = 0; i < 16; ++i) o[i] = (f32x4){0.f, 0.f, 0.f, 0.f};
        const float* vr = pq->in[I_CV] + ((size_t)(b * PAST) * NH + h) * HD + d4;
#pragma unroll 5
        for (int k = 0; k < 65; ++k) { const int sidx = kg * 65 + k; f32x4 v;
            if (sidx < PAST) v = __builtin_nontemporal_load((const f32x4*)(vr + (size_t)sidx * NH * HD));
            else { const u32x2 vw = *(const u32x2*)(Vb + (size_t)(SEQ + b * 16 + sidx - PAST) * DM + h * HD + d4); v = (f32x4){bflo(vw.x), bfhi(vw.x), bflo(vw.y), bfhi(vw.y)}; }
#pragma unroll
            for (int i = 0; i < 16; ++i) o[i] += v * S[i * TKS + sidx]; }
#pragma unroll
        for (int i = 0; i < 16; ++i) { o[i].x += __shfl_xor(o[i].x, 32); o[i].y += __shfl_xor(o[i].y, 32); o[i].z += __shfl_xor(o[i].z, 32); o[i].w += __shfl_xor(o[i].w, 32); }
        __syncthreads();
        if ((tid & 32) == 0) {
#pragma unroll
            for (int i = 0; i < 16; ++i) *(LAS f32x4*)(S + ((tid >> 6) * 16 + i) * 128 + d4) = o[i]; }
        __syncthreads();
        for (int idx = tid; idx < 2048; idx += NTHR) { const int i = idx >> 7, d = idx & 127; float a = 0.f;
#pragma unroll
            for (int w8 = 0; w8 < 8; ++w8) a += S[(w8 * 16 + i) * 128 + d];
            WSP(bf16_t, WS_H)[(size_t)(SEQ + b * 16 + i) * DM + h * HD + d] = f2bf1(a * inv[i]); }
    }
}

__device__ __forceinline__ void ssd_seq(PP pq, LAS unsigned char* lds, int tid, int row0, int L, int TB, int head, const float* init, float* outst, const float* convinit) {
    const bf16_t* XBC = WSP(bf16_t, WS_XBC); bf16_t* Z = WSP(bf16_t, WS_Z); const float* DT = WSP(float, WS_DT);
    LAS float* xs = (LAS float*)lds; LAS float* Bc = xs + 64 * 64; LAS float* Cc = Bc + 64 * 128; LAS float* zl = Cc + 64 * 128; LAS float* yl = zl + 64 * 64; LAS float* dtl = yl + 64 * 64;
    const int g = head >> 2, pp = tid >> 3, ns = tid & 7, n0 = ns * 16;
    const float A = -__expf(pq->in[I_ALOG][head]), Dh = pq->in[I_DSKIP][head];
    const float* cw = pq->in[I_CW]; const float* cbias = pq->in[I_CB];
    float s[16];
#pragma unroll
    for (int j = 0; j < 16; ++j) s[j] = init ? init[(size_t)(head * SP + pp) * SN + n0 + j] : 0.f;
    for (int t0 = 0; t0 < L; t0 += TB) {
        __syncthreads();
#pragma unroll 1
        for (int idx = tid; idx < TB * 320; idx += NTHR) { const int tt = idx / 320, cc = idx - tt * 320;
            const int ch = cc < 64 ? head * 64 + cc : (cc < 192 ? 1024 + g * 128 + (cc - 64) : 1536 + g * 128 + (cc - 192));
            float a = cbias[ch];
#pragma unroll
            for (int i = 0; i < 4; ++i) { const int tr = t0 + tt - 3 + i; float xv;
                if (tr >= 0) xv = bf2f(XBC[(size_t)(row0 + tr) * CONVD + ch]); else xv = convinit ? convinit[(3 + tr) * CONVD + ch] : 0.f;
                a += cw[i * CONVD + ch] * xv; }
            a = siluf_(a);
            if (cc < 64) xs[tt * 64 + cc] = a; else if (cc < 192) Bc[tt * 128 + cc - 64] = a; else Cc[tt * 128 + cc - 192] = a; }
#pragma unroll 1
        for (int idx = tid; idx < TB * 64; idx += NTHR) { const int tt = idx >> 6, c = idx & 63; zl[idx] = bf2f(Z[(size_t)(row0 + t0 + tt) * DM + head * 64 + c]); }
        if (tid < TB) dtl[tid] = DT[(size_t)(row0 + t0 + tid) * 16 + head];
        __syncthreads();
#pragma unroll 2
        for (int tt = 0; tt < TB; ++tt) {
            const float dtv = dtl[tt], dA = __expf(dtv * A), x = xs[tt * 64 + pp], xdt = x * dtv; float y = 0.f;
#pragma unroll
            for (int j4 = 0; j4 < 4; ++j4) { const f32x4 bv = *(const LAS f32x4*)(Bc + tt * 128 + n0 + 4 * j4), cv = *(const LAS f32x4*)(Cc + tt * 128 + n0 + 4 * j4);
#pragma unroll
                for (int j = 0; j < 4; ++j) { s[4 * j4 + j] = s[4 * j4 + j] * dA + xdt * bv[j]; y += cv[j] * s[4 * j4 + j]; } }
            y += __shfl_xor(y, 1); y += __shfl_xor(y, 2); y += __shfl_xor(y, 4);
            if (ns == 0) yl[tt * 64 + pp] = (y + Dh * x) * siluf_(zl[tt * 64 + pp]);
        }
        __syncthreads();
#pragma unroll 1
        for (int idx = tid; idx < TB * 64; idx += NTHR) { const int tt = idx >> 6, c = idx & 63; WSP(bf16_t, WS_YS)[(size_t)(row0 + t0 + tt) * DM + head * 64 + c] = f2bf1(yl[idx]); }
    }
#pragma unroll
    for (int j4 = 0; j4 < 4; ++j4) *(f32x4*)(outst + (size_t)(head * SP + pp) * SN + n0 + 4 * j4) = (f32x4){s[4 * j4], s[4 * j4 + 1], s[4 * j4 + 2], s[4 * j4 + 3]};
}
constexpr int SD_CN = 0, SD_BN = 17408, SD_BT = 34816, SD_XT = 53248, SD_ACS = 90112, SD_DTL = 91136, SD_WL = 92160;
constexpr int CNS = 136, XTS = 72;
typedef float f32x16 __attribute__((ext_vector_type(16)));
#define MFMA32(a, b, c) __builtin_amdgcn_mfma_f32_32x32x16_bf16((a), (b), (c), 0, 0, 0)
__device__ __forceinline__ void ssd_stage(PP pq, LAS unsigned char* lds, int tid, int lane, int wave, int row0, int ntok, int g, const float* convinit, const int mode) {
    const bf16_t* XBC = WSP(bf16_t, WS_XBC);
    const int cb = tid & 63, tg = tid >> 6;
    const int ch = cb < 32 ? g * 256 + 8 * cb : (cb < 48 ? 1024 + g * 128 + 8 * (cb - 32) : 1536 + g * 128 + 8 * (cb - 48));
    const float* cw = pq->in[I_CW]; const float* cbs = pq->in[I_CB];
    if (tg * 8 < ntok && (mode == 1 || cb < 48)) {
    float w[4][8], y[8][8];
#pragma unroll
    for (int i = 0; i < 4; ++i) { const f32x4 a = *(const f32x4*)(cw + i * CONVD + ch), b = *(const f32x4*)(cw + i * CONVD + ch + 4);
        w[i][0] = a.x; w[i][1] = a.y; w[i][2] = a.z; w[i][3] = a.w; w[i][4] = b.x; w[i][5] = b.y; w[i][6] = b.z; w[i][7] = b.w; }
    { const f32x4 a = *(const f32x4*)(cbs + ch), b = *(const f32x4*)(cbs + ch + 4);
#pragma unroll
        for (int t = 0; t < 8; ++t) { y[t][0] = a.x; y[t][1] = a.y; y[t][2] = a.z; y[t][3] = a.w; y[t][4] = b.x; y[t][5] = b.y; y[t][6] = b.z; y[t][7] = b.w; } }
#pragma unroll
    for (int k = 0; k < 11; ++k) { const int rel = 8 * tg - 3 + k; u32x4 v = (u32x4){0u, 0u, 0u, 0u};
        float x[8];
        if (rel < 0 && convinit) { const f32x4 a = *(const f32x4*)(convinit + (size_t)(3 + rel) * CONVD + ch), b = *(const f32x4*)(convinit + (size_t)(3 + rel) * CONVD + ch + 4);
            x[0] = a.x; x[1] = a.y; x[2] = a.z; x[3] = a.w; x[4] = b.x; x[5] = b.y; x[6] = b.z; x[7] = b.w; }
        else { if (row0 + rel >= 0) v = *(const u32x4*)(XBC + (size_t)(row0 + rel) * CONVD + ch);
            x[0] = bflo(v.x); x[1] = bfhi(v.x); x[2] = bflo(v.y); x[3] = bfhi(v.y); x[4] = bflo(v.z); x[5] = bfhi(v.z); x[6] = bflo(v.w); x[7] = bfhi(v.w); }
#pragma unroll
        for (int i = 0; i < 4; ++i) { const int t = k - i;
            if (t >= 0 && t < 8) {
#pragma unroll
                for (int e = 0; e < 8; ++e) y[t][e] += w[i][e] * x[e]; } } }
#pragma unroll
    for (int t = 0; t < 8; ++t)
#pragma unroll
        for (int e = 0; e < 8; ++e) y[t][e] = siluf_(y[t][e]);
    LAS bf16_t* CN = (LAS bf16_t*)(lds + SD_CN); LAS bf16_t* BN = (LAS bf16_t*)(lds + SD_BN); LAS bf16_t* BT = (LAS bf16_t*)(lds + SD_BT); LAS bf16_t* XT = (LAS bf16_t*)(lds + SD_XT);
    if (cb < 32) { const int r = cb >> 3, p0 = (cb & 7) * 8;
#pragma unroll
        for (int e = 0; e < 8; ++e) *(LAS u32x4*)(XT + (r * 64 + p0 + e) * XTS + 8 * tg) = (u32x4){cvtpk_c(y[0][e], y[1][e]), cvtpk_c(y[2][e], y[3][e]), cvtpk_c(y[4][e], y[5][e]), cvtpk_c(y[6][e], y[7][e])};
    } else if (cb < 48) { const int n0 = (cb - 32) * 8;
        if (mode == 1) {
#pragma unroll
        for (int t = 0; t < 8; ++t) *(LAS u32x4*)(BN + (8 * tg + t) * CNS + n0) = (u32x4){cvtpk_c(y[t][0], y[t][1]), cvtpk_c(y[t][2], y[t][3]), cvtpk_c(y[t][4], y[t][5]), cvtpk_c(y[t][6], y[t][7])};
        } else {
#pragma unroll
        for (int e = 0; e < 8; ++e) *(LAS u32x4*)(BT + (n0 + e) * XTS + 8 * tg) = (u32x4){cvtpk_c(y[0][e], y[1][e]), cvtpk_c(y[2][e], y[3][e]), cvtpk_c(y[4][e], y[5][e]), cvtpk_c(y[6][e], y[7][e])};
        }
    } else { const int n0 = (cb - 48) * 8;
#pragma unroll
        for (int t = 0; t < 8; ++t) *(LAS u32x4*)(CN + (8 * tg + t) * CNS + n0) = (u32x4){cvtpk_c(y[t][0], y[t][1]), cvtpk_c(y[t][2], y[t][3]), cvtpk_c(y[t][4], y[t][5]), cvtpk_c(y[t][6], y[t][7])};
    }
    }
    if (wave < 4) { const int hd = 4 * g + wave; const float A = -__expf(pq->in[I_ALOG][hd]);
        const float dtv = lane < ntok ? WSP(float, WS_DT)[(size_t)(row0 + lane) * 16 + hd] : 0.f; float acs = dtv * A;
#pragma unroll
        for (int o = 1; o < 64; o <<= 1) { const float t = __shfl_up(acs, o); if (lane >= o) acs += t; }
        const float tot = __shfl(acs, 63);
        LAS float* ACS = (LAS float*)(lds + SD_ACS); LAS float* DTL = (LAS float*)(lds + SD_DTL); LAS float* WL = (LAS float*)(lds + SD_WL);
        ACS[wave * 64 + lane] = acs; DTL[wave * 64 + lane] = dtv; WL[wave * 64 + lane] = dtv * __expf(tot - acs); }
}
__device__ __forceinline__ void unpack8(const u32x4 a, float (&f)[8]) { f[0] = bflo(a.x); f[1] = bfhi(a.x); f[2] = bflo(a.y); f[3] = bfhi(a.y); f[4] = bflo(a.z); f[5] = bfhi(a.z); f[6] = bflo(a.w); f[7] = bfhi(a.w); }
template <int NV, int RL>
__device__ __forceinline__ void merge_thread(PP pq, int row, int col, const LAS float* yl) {
    const bool smp = row >= SEQ; const size_t ro = (size_t)row * DM + col; const size_t so = (size_t)(row - SEQ) * DM + col;
    const bf16_t* Zp = WSP(bf16_t, WS_Z) + ro; bf16_t* Hp = WSP(bf16_t, WS_H) + ro;
    const bf16_t* gap = smp ? WSP(bf16_t, WS_GAS) + so : (const bf16_t*)(pq->out + O_YP) + ro;
    const bf16_t* gbp = smp ? WSP(bf16_t, WS_GBS) + so : (const bf16_t*)(pq->out + O_YP) + (size_t)SEQ * DM + ro;
    const float* sng = pq->in[I_SNG] + col;
    float y[NV][8]; float ss = 0.f;
#pragma unroll
    for (int v = 0; v < NV; ++v) { float z[8]; unpack8(*(const u32x4*)(Zp + 8 * v), z); const f32x4 y0 = *(const LAS f32x4*)(yl + 8 * v), y1 = *(const LAS f32x4*)(yl + 8 * v + 4);
#pragma unroll
        for (int e = 0; e < 8; ++e) { const float yy = (e < 4 ? y0[e & 3] : y1[e & 3]) * siluf_(z[e]); y[v][e] = yy; ss += yy * yy; } }
#pragma unroll
    for (int o = 1; o < RL; o <<= 1) ss += __shfl_xor(ss, o);
    const float rstd = 1.f / sqrtf(ss * (1.f / 256.f) + EPS);
#pragma unroll
    for (int v = 0; v < NV; ++v) { float ya[8], ga[8], gb[8]; unpack8(*(const u32x4*)(Hp + 8 * v), ya); unpack8(*(const u32x4*)(gap + 8 * v), ga); unpack8(*(const u32x4*)(gbp + 8 * v), gb);
        const f32x4 g0 = *(const f32x4*)(sng + 8 * v), g1 = *(const f32x4*)(sng + 8 * v + 4); float m[8];
#pragma unroll
        for (int e = 0; e < 8; ++e) m[e] = sigmoidf_(ga[e]) * ya[e] + sigmoidf_(gb[e]) * (y[v][e] * rstd * (e < 4 ? g0[e & 3] : g1[e & 3]));
        *(u32x4*)(Hp + 8 * v) = (u32x4){pk2(m[0], m[1]), pk2(m[2], m[3]), pk2(m[4], m[5]), pk2(m[6], m[7])}; }
}
constexpr int YLS = 260;
constexpr size_t ST_CH = (size_t)SH * SP * SN;
__device__ __forceinline__ void ssd_passA(PP pq, LAS unsigned char* lds, int tid, int lane, int wave) {
    LAS bf16_t* BT = (LAS bf16_t*)(lds + SD_BT); LAS bf16_t* XT = (LAS bf16_t*)(lds + SD_XT); LAS float* WL = (LAS float*)(lds + SD_WL); LAS float* ACS = (LAS float*)(lds + SD_ACS);
    for (int u = blockIdx.x; u < 1024; u += gridDim.x) { const int c = u >> 2, g = u & 3;
        __syncthreads(); ssd_stage(pq, lds, tid, lane, wave, 64 * c, 64, g, nullptr, 0); __syncthreads();
        const int r = wave >> 1, nh = wave & 1, hd = 4 * g + r, cl = lane & 31, hi = lane >> 5;
        f32x16 acc[2][2];
#pragma unroll
        for (int a = 0; a < 2; ++a)
#pragma unroll
            for (int b = 0; b < 2; ++b)
#pragma unroll
                for (int i = 0; i < 16; ++i) acc[a][b][i] = 0.f;
#pragma unroll
        for (int ks = 0; ks < 4; ++ks) {
            const f32x4 w0 = *(const LAS f32x4*)(WL + r * 64 + 16 * ks + 8 * hi), w1 = *(const LAS f32x4*)(WL + r * 64 + 16 * ks + 8 * hi + 4);
            bf16x8 Bf[2];
#pragma unroll
            for (int pt = 0; pt < 2; ++pt) { const u32x4 raw = *(const LAS u32x4*)(XT + (r * 64 + 32 * pt + cl) * XTS + 16 * ks + 8 * hi);
                u32x4 sc; sc.x = cvtpk_c(bflo(raw.x) * w0.x, bfhi(raw.x) * w0.y); sc.y = cvtpk_c(bflo(raw.y) * w0.z, bfhi(raw.y) * w0.w);
                sc.z = cvtpk_c(bflo(raw.z) * w1.x, bfhi(raw.z) * w1.y); sc.w = cvtpk_c(bflo(raw.w) * w1.z, bfhi(raw.w) * w1.w);
                Bf[pt] = __builtin_bit_cast(bf16x8, sc); }
#pragma unroll
            for (int nt2 = 0; nt2 < 2; ++nt2) { const bf16x8 Af = *(const LAS bf16x8*)(BT + (32 * (2 * nh + nt2) + cl) * XTS + 16 * ks + 8 * hi);
#pragma unroll
                for (int pt = 0; pt < 2; ++pt) acc[nt2][pt] = MFMA32(Af, Bf[pt], acc[nt2][pt]); }
        }
        bf16_t* ST = WSP(bf16_t, WS_ST) + (size_t)(c * 16 + hd) * (SP * SN);
#pragma unroll
        for (int nt2 = 0; nt2 < 2; ++nt2)
#pragma unroll
            for (int pt = 0; pt < 2; ++pt)
#pragma unroll
                for (int q = 0; q < 4; ++q) { const int n = 32 * (2 * nh + nt2) + 8 * q + 4 * hi, pp = 32 * pt + cl;
                    u32x2 wv; wv.x = cvtpk_c(acc[nt2][pt][4 * q], acc[nt2][pt][4 * q + 1]); wv.y = cvtpk_c(acc[nt2][pt][4 * q + 2], acc[nt2][pt][4 * q + 3]);
                    *(u32x2*)(ST + ((n >> 2) * SP + pp) * 4) = wv; }
        if (lane == 0 && nh == 0) WSP(float, WS_CDEC)[c * 16 + hd] = __expf(ACS[r * 64 + 63]);
    }
}
__device__ __forceinline__ void ssd_scan(PP pq, int tid) {
    bf16_t* ST = WSP(bf16_t, WS_ST); const float* CDEC = WSP(float, WS_CDEC);
    for (int e = blockIdx.x * NTHR + tid; e < (int)ST_CH; e += gridDim.x * NTHR) { const int hd = e >> 13; float s = 0.f;
        for (int c0 = 0; c0 < 256; c0 += 32) { float v[32], d[32];
#pragma unroll
            for (int k = 0; k < 32; ++k) { v[k] = bf2f(ST[(size_t)(c0 + k) * ST_CH + e]); d[k] = CDEC[(c0 + k) * 16 + hd]; }
#pragma unroll
            for (int k = 0; k < 32; ++k) { ST[(size_t)(c0 + k) * ST_CH + e] = f2bf1(s); s = s * d[k] + v[k]; } }
        { const int el = e & 8191, nb = el >> 8, pp = (el >> 2) & 63, j = el & 3; pq->out[O_PS + (size_t)hd * 8192 + pp * SN + 4 * nb + j] = s; } }
}
__device__ __forceinline__ void ssd_passC(PP pq, LAS unsigned char* lds, int tid, int lane, int wave) {
    LAS bf16_t* CN = (LAS bf16_t*)(lds + SD_CN); LAS bf16_t* BN = (LAS bf16_t*)(lds + SD_BN); LAS bf16_t* XT = (LAS bf16_t*)(lds + SD_XT);
    LAS float* ACS = (LAS float*)(lds + SD_ACS); LAS float* DTL = (LAS float*)(lds + SD_DTL);
    const bf16_t* Z = WSP(bf16_t, WS_Z); bf16_t* YS = WSP(bf16_t, WS_YS);
    for (int u = blockIdx.x; u < 1024; u += gridDim.x) { const int c = u >> 2, g = u & 3;
        __syncthreads(); ssd_stage(pq, lds, tid, lane, wave, 64 * c, 64, g, nullptr, 1); __syncthreads();
        const int r = wave >> 1, lt = wave & 1, hd = 4 * g + r, cl = lane & 31, hi = lane >> 5;
        const bf16_t* SPv = WSP(bf16_t, WS_ST) + (size_t)(c * 16 + hd) * (SP * SN);
        f32x16 acc[2];
#pragma unroll
        for (int b = 0; b < 2; ++b)
#pragma unroll
            for (int i = 0; i < 16; ++i) acc[b][i] = 0.f;
#pragma unroll
        for (int ks = 0; ks < 8; ++ks) { const bf16x8 Af = *(const LAS bf16x8*)(CN + (32 * lt + cl) * CNS + 16 * ks + 8 * hi);
#pragma unroll
            for (int pt = 0; pt < 2; ++pt) { const int nb0 = 4 * ks + 2 * hi, pp = 32 * pt + cl; const u32x2 lo2 = *(const u32x2*)(SPv + (nb0 * SP + pp) * 4), hi2 = *(const u32x2*)(SPv + ((nb0 + 1) * SP + pp) * 4);
                const u32x4 bw = (u32x4){lo2.x, lo2.y, hi2.x, hi2.y}; acc[pt] = MFMA32(Af, __builtin_bit_cast(bf16x8, bw), acc[pt]); } }
#pragma unroll
        for (int q = 0; q < 4; ++q) { const f32x4 a4 = *(const LAS f32x4*)(ACS + r * 64 + 32 * lt + 8 * q + 4 * hi);
#pragma unroll
            for (int j = 0; j < 4; ++j) { const float e = __expf(a4[j]); acc[0][4 * q + j] *= e; acc[1][4 * q + j] *= e; } }
        const float al = ACS[r * 64 + 32 * lt + cl];
        for (int st = 0; st <= lt; ++st) {
            f32x16 X;
#pragma unroll
            for (int i = 0; i < 16; ++i) X[i] = 0.f;
#pragma unroll
            for (int ks = 0; ks < 8; ++ks) { const bf16x8 Af = *(const LAS bf16x8*)(BN + (32 * st + cl) * CNS + 16 * ks + 8 * hi), Bf = *(const LAS bf16x8*)(CN + (32 * lt + cl) * CNS + 16 * ks + 8 * hi);
                X = MFMA32(Af, Bf, X); }
#pragma unroll
            for (int q = 0; q < 4; ++q) { const f32x4 as4 = *(const LAS f32x4*)(ACS + r * 64 + 32 * st + 8 * q + 4 * hi), ds4 = *(const LAS f32x4*)(DTL + r * 64 + 32 * st + 8 * q + 4 * hi);
#pragma unroll
                for (int j = 0; j < 4; ++j) { const int s = 32 * st + 8 * q + 4 * hi + j; const float v = X[4 * q + j] * __expf(fminf(al - as4[j], 0.f)) * ds4[j]; X[4 * q + j] = (s <= 32 * lt + cl) ? v : 0.f; } }
            bf16x8 pa[2];
#pragma unroll
            for (int s2 = 0; s2 < 2; ++s2) { u32x4 pw; pw.x = cvtpk_c(X[8 * s2], X[8 * s2 + 1]); pw.y = cvtpk_c(X[8 * s2 + 2], X[8 * s2 + 3]); pw.z = cvtpk_c(X[8 * s2 + 4], X[8 * s2 + 5]); pw.w = cvtpk_c(X[8 * s2 + 6], X[8 * s2 + 7]);
                pa[s2] = __builtin_bit_cast(bf16x8, pw); }
#pragma unroll
            for (int pt = 0; pt < 2; ++pt)
#pragma unroll
                for (int s2 = 0; s2 < 2; ++s2) { const LAS bf16_t* xp = XT + (r * 64 + 32 * pt + cl) * XTS + 32 * st + 16 * s2 + 4 * hi;
                    const u32x2 lo2 = *(const LAS u32x2*)xp, hi2 = *(const LAS u32x2*)(xp + 8); const u32x4 bw = (u32x4){lo2.x, lo2.y, hi2.x, hi2.y};
                    acc[pt] = MFMA32(pa[s2], __builtin_bit_cast(bf16x8, bw), acc[pt]); }
        }
        const float Dh = pq->in[I_DSKIP][hd]; float yv[2][16];
#pragma unroll
        for (int pt = 0; pt < 2; ++pt)
#pragma unroll
            for (int q = 0; q < 4; ++q) { const int pp = 32 * pt + cl, l0 = 32 * lt + 8 * q + 4 * hi;
                const u32x2 xw = *(const LAS u32x2*)(XT + (r * 64 + pp) * XTS + l0);
                yv[pt][4 * q] = acc[pt][4 * q] + Dh * bflo(xw.x); yv[pt][4 * q + 1] = acc[pt][4 * q + 1] + Dh * bfhi(xw.x); yv[pt][4 * q + 2] = acc[pt][4 * q + 2] + Dh * bflo(xw.y); yv[pt][4 * q + 3] = acc[pt][4 * q + 3] + Dh * bfhi(xw.y); }
        __syncthreads();
        LAS float* YL = (LAS float*)lds;
#pragma unroll
        for (int pt = 0; pt < 2; ++pt)
#pragma unroll
            for (int q = 0; q < 4; ++q)
#pragma unroll
                for (int j = 0; j < 4; ++j) YL[(32 * lt + 8 * q + 4 * hi + j) * YLS + r * 64 + 32 * pt + cl] = yv[pt][4 * q + j];
        __syncthreads();
        { const int l = tid >> 3, cs = (tid & 7) * 32; merge_thread<4, 8>(pq, 64 * c + l, g * 256 + cs, YL + l * YLS + cs); }
    }
}

__device__ __forceinline__ void ssd_seq4(PP pq, LAS unsigned char* lds, int tid, int lane, int wave, int b, int g) {
    const int row0 = SEQ + b * NSL;
    __syncthreads(); ssd_stage(pq, lds, tid, lane, wave, row0, NSL, g, pq->in[I_SCONV] + (size_t)b * 3 * CONVD, 1); __syncthreads();
    LAS bf16_t* CN = (LAS bf16_t*)(lds + SD_CN); LAS bf16_t* BN = (LAS bf16_t*)(lds + SD_BN); LAS bf16_t* XT = (LAS bf16_t*)(lds + SD_XT); LAS float* DTL = (LAS float*)(lds + SD_DTL);
    LAS float* YL = (LAS float*)(lds + 94208);
    const int r = tid >> 7, pp = (tid & 127) >> 1, nh = tid & 1, n0 = nh * 64, hd = 4 * g + r;
    const float A = -__expf(pq->in[I_ALOG][hd]), Dh = pq->in[I_DSKIP][hd];
    const float* sin_ = pq->in[I_SSM] + ((size_t)(b * SH + hd) * SP + pp) * SN + n0; float* sout = pq->out + O_SS + ((size_t)(b * SH + hd) * SP + pp) * SN + n0;
    float st[64];
#pragma unroll
    for (int j4 = 0; j4 < 16; ++j4) { const f32x4 v = *(const f32x4*)(sin_ + 4 * j4); st[4 * j4] = v.x; st[4 * j4 + 1] = v.y; st[4 * j4 + 2] = v.z; st[4 * j4 + 3] = v.w; }
#pragma unroll 1
    for (int t = 0; t < NSL; ++t) {
        const float dtv = DTL[r * 64 + t], dA = __expf(dtv * A), x = bf2f(XT[(r * 64 + pp) * XTS + t]), xdt = x * dtv; float y = 0.f;
#pragma unroll
        for (int j4 = 0; j4 < 16; ++j4) { const u32x2 bw = *(const LAS u32x2*)(BN + t * CNS + n0 + 4 * j4), cw2 = *(const LAS u32x2*)(CN + t * CNS + n0 + 4 * j4);
            st[4 * j4] = st[4 * j4] * dA + xdt * bflo(bw.x); y += bflo(cw2.x) * st[4 * j4];
            st[4 * j4 + 1] = st[4 * j4 + 1] * dA + xdt * bfhi(bw.x); y += bfhi(cw2.x) * st[4 * j4 + 1];
            st[4 * j4 + 2] = st[4 * j4 + 2] * dA + xdt * bflo(bw.y); y += bflo(cw2.y) * st[4 * j4 + 2];
            st[4 * j4 + 3] = st[4 * j4 + 3] * dA + xdt * bfhi(bw.y); y += bfhi(cw2.y) * st[4 * j4 + 3]; }
        y += __shfl_xor(y, 1);
        if (nh == 0) YL[t * YLS + r * 64 + pp] = y + Dh * x;
    }
#pragma unroll
    for (int j4 = 0; j4 < 16; ++j4) *(f32x4*)(sout + 4 * j4) = (f32x4){st[4 * j4], st[4 * j4 + 1], st[4 * j4 + 2], st[4 * j4 + 3]};
    __syncthreads();
    { const int t = tid >> 5, cs = (tid & 31) * 8; merge_thread<1, 32>(pq, row0 + t, g * 256 + cs, YL + t * YLS + cs); }
}
__device__ __forceinline__ void sample_ssd4_units(PP pq, LAS unsigned char* lds, int tid, int lane, int wave) {
    for (int v = blockIdx.x; v < NSB * SG; v += gridDim.x) ssd_seq4(pq, lds, tid, lane, wave, v >> 2, v & 3);
}

template <int EPI>
__device__ __forceinline__ void small_gemm(const bf16_t* __restrict__ A, const bf16_t* __restrict__ Bt, int N, int K, void* Out, int ldo, LAS unsigned char* lds, int tid, int lane, int wave) {
    const int nct = N / 64, nitems = 4 * nct, cl = lane & 31, hi = lane >> 5, kw = K / 8;
    LAS float* RED = (LAS float*)lds;
    for (int it = blockIdx.x; it < nitems; it += gridDim.x) { const int mt = it / nct, nt = it - mt * nct;
        f32x16 acc[2][2];
#pragma unroll
        for (int a = 0; a < 2; ++a)
#pragma unroll
            for (int b = 0; b < 2; ++b)
#pragma unroll
                for (int i = 0; i < 16; ++i) acc[a][b][i] = 0.f;
        const bf16_t* a0 = A + (size_t)(64 * mt + cl) * K + wave * kw + 8 * hi; const bf16_t* b0 = Bt + (size_t)(64 * nt + cl) * K + wave * kw + 8 * hi;
#pragma unroll 4
        for (int ks = 0; ks < kw / 16; ++ks) {
            const bf16x8 A0 = *(const bf16x8*)(a0 + 16 * ks), A1 = *(const bf16x8*)(a0 + (size_t)32 * K + 16 * ks), B0 = *(const bf16x8*)(b0 + 16 * ks), B1 = *(const bf16x8*)(b0 + (size_t)32 * K + 16 * ks);
            acc[0][0] = MFMA32(A0, B0, acc[0][0]); acc[0][1] = MFMA32(A0, B1, acc[0][1]); acc[1][0] = MFMA32(A1, B0, acc[1][0]); acc[1][1] = MFMA32(A1, B1, acc[1][1]); }
        __syncthreads();
#pragma unroll
        for (int a = 0; a < 2; ++a)
#pragma unroll
            for (int b = 0; b < 2; ++b)
#pragma unroll
                for (int i = 0; i < 16; ++i) RED[(wave * 64 + 32 * a + (i & 3) + 8 * (i >> 2) + 4 * hi) * 64 + 32 * b + cl] = acc[a][b][i];
        __syncthreads();
#pragma unroll
        for (int qd = 0; qd < 2; ++qd) { const int e = tid + NTHR * qd, row = e >> 4, c4 = (e & 15) * 4; f32x4 sum = (f32x4){0.f, 0.f, 0.f, 0.f};
#pragma unroll
            for (int w8 = 0; w8 < 8; ++w8) sum += *(const LAS f32x4*)(RED + (w8 * 64 + row) * 64 + c4);
            if (EPI == 0) *(f32x4*)((float*)Out + (size_t)(64 * mt + row) * ldo + 64 * nt + c4) = sum;
            else if (EPI == 2) { u32x2 wv; wv.x = cvtpk_c(sum.x, sum.y); wv.y = cvtpk_c(sum.z, sum.w); *(u32x2*)((bf16_t*)Out + (size_t)(64 * mt + row) * ldo + 64 * nt + c4) = wv; }
            else { const float r0 = fmaxf(sum.x, 0.f), r1 = fmaxf(sum.y, 0.f), r2 = fmaxf(sum.z, 0.f), r3 = fmaxf(sum.w, 0.f); u32x2 wv; wv.x = cvtpk_c(r0 * r0, r1 * r1); wv.y = cvtpk_c(r2 * r2, r3 * r3);
                *(u32x2*)((bf16_t*)Out + (size_t)(64 * mt + row) * ldo + 64 * nt + c4) = wv; } }
    }
    __syncthreads();
}

__device__ __forceinline__ void sample_attn_units(PP pq, LAS unsigned char* lds, int tid) {
    for (int u = blockIdx.x; u < 128; u += gridDim.x) sample_attn(pq, lds, tid, u >> 3, u & 7);
}
__device__ __forceinline__ void sample_ssd_units(PP pq, LAS unsigned char* lds, int tid) {
    for (int v = blockIdx.x; v < 256; v += gridDim.x) { const int b = v >> 4, hd = v & 15;
        ssd_seq(pq, lds, tid, SEQ + b * 16, NSL, 16, hd, pq->in[I_SSM] + (size_t)b * SH * SP * SN, pq->out + O_SS + (size_t)b * SH * SP * SN, pq->in[I_SCONV] + (size_t)b * 3 * CONVD); }
}

__device__ __forceinline__ void phase6(PP pq, int lane, int gw, int ngw) {
    const bf16_t* Qb = WSP(bf16_t, WS_Q); const bf16_t* Zb = WSP(bf16_t, WS_Z); bf16_t* H = WSP(bf16_t, WS_H); const float* sng = pq->in[I_SNG];
    for (int row = gw; row < R; row += ngw) {
        const bool smp = row >= SEQ; const int srow = row - SEQ; const size_t ro = (size_t)row * DM + 16 * lane;
        const bf16_t* gap = smp ? WSP(bf16_t, WS_GAS) + (size_t)srow * DM + 16 * lane : (const bf16_t*)(pq->out + O_YP) + ro;
        const bf16_t* gbp = smp ? WSP(bf16_t, WS_GBS) + (size_t)srow * DM + 16 * lane : (const bf16_t*)(pq->out + O_YP) + (size_t)SEQ * DM + ro;
        float ya[16], ys[16], ga[16], gb[16];
        unpack16(H + ro, ya); unpack16(WSP(bf16_t, WS_YS) + ro, ys); unpack16(gap, ga); unpack16(gbp, gb);
        float ss = 0.f;
#pragma unroll
        for (int e = 0; e < 16; ++e) ss += ys[e] * ys[e];
        ss += __shfl_xor(ss, 1); ss += __shfl_xor(ss, 2); ss += __shfl_xor(ss, 4); ss += __shfl_xor(ss, 8);
        const float rstd = 1.f / sqrtf(ss * (1.f / 256.f) + EPS);
        float m[16];
#pragma unroll
        for (int e4 = 0; e4 < 4; ++e4) { const f32x4 gg = *(const f32x4*)(sng + 16 * lane + 4 * e4);
#pragma unroll
            for (int j = 0; j < 4; ++j) { const int e = 4 * e4 + j; m[e] = sigmoidf_(ga[e]) * ya[e] + sigmoidf_(gb[e]) * (ys[e] * rstd * gg[j]); } }
        u32x4 w0, w1; w0.x = pk2(m[0], m[1]); w0.y = pk2(m[2], m[3]); w0.z = pk2(m[4], m[5]); w0.w = pk2(m[6], m[7]);
        w1.x = pk2(m[8], m[9]); w1.y = pk2(m[10], m[11]); w1.z = pk2(m[12], m[13]); w1.w = pk2(m[14], m[15]);
        *(u32x4*)(H + ro) = w0; *(u32x4*)(H + ro + 8) = w1;
    }
}

__device__ __forceinline__ void phase8(PP pq, int lane, int gw, int ngw) {
    const float* mod = WSP(float, WS_MOD); const bf16_t* MF = WSP(bf16_t, WS_MF); bf16_t* H = WSP(bf16_t, WS_H); const float* gqm = pq->in[I_GQM];
    for (int row0 = gw; row0 < R; row0 += 2 * ngw) {
        const int r1 = row0 + ngw; const bool has1 = r1 < R; int rr[2] = {row0, has1 ? r1 : row0};
        f32x4 v[2][4], xv[2][4], x1[2][4]; float rs[2], rs2[2]; const float* mr[2];
#pragma unroll
        for (int a = 0; a < 2; ++a) { const u32x2* mr4 = (const u32x2*)(MF + (size_t)rr[a] * DM) + lane; const f32x4* xr = (const f32x4*)xrow_ptr(pq, rr[a]) + lane; mr[a] = mod + (size_t)modrow(rr[a]) * 6144;
#pragma unroll
            for (int j = 0; j < 4; ++j) { { const u32x2 mw = __builtin_nontemporal_load(mr4 + 64 * j);     v[a][j] = (f32x4){bflo(mw.x), bfhi(mw.x), bflo(mw.y), bfhi(mw.y)}; } xv[a][j] = xr[64 * j]; } }
#pragma unroll
        for (int a = 0; a < 2; ++a) rs[a] = 1.f / sqrtf(wave_sum(sumsq4(v[a])) * (1.f / DM) + EPS);
#pragma unroll
        for (int a = 0; a < 2; ++a) { f32x4* yr = (f32x4*)yrow_ptr(pq, rr[a]) + lane;
#pragma unroll
            for (int j = 0; j < 4; ++j) { const int c = 4 * lane + 256 * j; const f32x4 gt = *(const f32x4*)(mr[a] + 2048 + c), gg = *(const f32x4*)(gqm + c);
                x1[a][j] = xv[a][j] + gt * (v[a][j] * rs[a] * gg); if (a == 0 || has1) yr[64 * j] = x1[a][j]; } }
#pragma unroll
        for (int a = 0; a < 2; ++a) rs2[a] = 1.f / sqrtf(wave_sum(sumsq4(x1[a])) * (1.f / DM) + EPS);
        modnorm_store(x1[0], rs2[0], pq->in[I_GPF], mr[0] + 4096, mr[0] + 3072, H + (size_t)rr[0] * DM, lane);
        if (has1) modnorm_store(x1[1], rs2[1], pq->in[I_GPF], mr[1] + 4096, mr[1] + 3072, H + (size_t)rr[1] * DM, lane);
    }
}
__device__ __forceinline__ void phase11(PP pq, int lane, int gw, int ngw) {
    const float* mod = WSP(float, WS_MOD); const bf16_t* MF = WSP(bf16_t, WS_MF); const float* gqf = pq->in[I_GQF];
    for (int row0 = gw; row0 < R; row0 += 2 * ngw) {
        const int r1 = row0 + ngw; const bool has1 = r1 < R; int rr[2] = {row0, has1 ? r1 : row0};
        f32x4 v[2][4], yv[2][4]; float rs[2];
#pragma unroll
        for (int a = 0; a < 2; ++a) { const u32x2* fr4 = (const u32x2*)(MF + (size_t)rr[a] * DM) + lane; const f32x4* yr = (const f32x4*)yrow_ptr(pq, rr[a]) + lane;
#pragma unroll
            for (int j = 0; j < 4; ++j) { { const u32x2 fw = __builtin_nontemporal_load(fr4 + 64 * j); v[a][j] = (f32x4){bflo(fw.x), bfhi(fw.x), bflo(fw.y), bfhi(fw.y)}; } yv[a][j] = __builtin_nontemporal_load(yr + 64 * j); } }
#pragma unroll
        for (int a = 0; a < 2; ++a) rs[a] = 1.f / sqrtf(wave_sum(sumsq4(v[a])) * (1.f / DM) + EPS);
#pragma unroll
        for (int a = 0; a < 2; ++a) { if (a == 1 && !has1) break; f32x4* yr = (f32x4*)yrow_ptr(pq, rr[a]) + lane; const float* mr = mod + (size_t)modrow(rr[a]) * 6144;
#pragma unroll
            for (int j = 0; j < 4; ++j) { const int c = 4 * lane + 256 * j; const f32x4 gt = *(const f32x4*)(mr + 5120 + c), gg = *(const f32x4*)(gqf + c);
                yr[64 * j] = yv[a][j] + gt * (v[a][j] * rs[a] * gg); } }
    }
}

constexpr int NPHASE = 14;
__global__ void __launch_bounds__(NTHR, 2) fox_ssd_fwd(Params p) {
    extern __shared__ __attribute__((aligned(16))) unsigned char lds[];
    cg::grid_group grid = cg::this_grid();
    LAS unsigned char* ldsL = (LAS unsigned char*)lds;
    constexpr int BST_OFF = LDS_BYTES - 64;
    { PP q0 = kparams(); if (threadIdx.x < 2) ((volatile LAS unsigned*)(ldsL + BST_OFF))[threadIdx.x] = 0u; __syncthreads();
      if (q0->ph_hi - q0->ph_lo > 1) (void)xcd_barrier_post((unsigned*)(q0->ws + WS_BAR), (volatile LAS unsigned*)(ldsL + BST_OFF));
      if (q0->ph_lo < 0) grid.sync(); }
#define PV PP pq = kparams(); const int tid = launder_tid(), lane = tid & 63, wave = __builtin_amdgcn_readfirstlane(tid >> 6), gw = blockIdx.x * NWV + wave, ngw = gridDim.x * NWV; (void)lane; (void)gw; (void)ngw; (void)pq;
#ifndef ONLYP
#define ONLYP -1
#endif
#define IN(k) (in_phase(k) && (ONLYP < 0 || ONLYP == (k)))
#define GSYNC() do { XcdBarrier bar_; bar_.bar = (unsigned*)(kparams()->ws + WS_BAR); bar_.x = xb_xcc_id(); bar_.st = (volatile LAS unsigned*)(ldsL + BST_OFF); xcd_barrier(bar_); } while (0)
#define SEAM(k) do { if (IN(k) && IN((k) + 1)) GSYNC(); } while (0)
#ifndef REP_MASK
#define REP_MASK 0
#endif
#define PHASE(k, ...) do { if (IN(k)) { for (int rep_ = 0; rep_ <= ((REP_MASK >> (k)) & 1); ++rep_) { if (rep_) GSYNC(); PV __VA_ARGS__ } } SEAM(k); } while (0)
    PHASE(0, phase0(pq, ldsL, tid, lane, wave););
    PHASE(1, phase1(pq, lane, gw, ngw););
    PHASE(2, pg8::Gemm g{WSP(pg8::bf16_t, WS_H), WSP(pg8::bf16_t, WS_WTIN), R, NIN, DM}; pg8::StaticOrder S; S.init(R, NIN, gridDim.x, blockIdx.x); pg8::EpiIn E{0};
        pg8::gemm_phase<pg8::EpiIn, pg8::StaticOrder, true, true>(ldsL, g, S, E);
        { const int G = gridDim.x, nun = (R / 256) * (NIN / 256), rounds = (nun + G - 1) / G, r0 = nun - (rounds - 1) * G;
          __syncthreads();
          if (r0 >= G) late_transposes(pq, ldsL, tid, (int)blockIdx.x, G);
          else if ((int)blockIdx.x >= r0) late_transposes(pq, ldsL, tid, (int)blockIdx.x - r0, G - r0); });
    PHASE(3, phase3(pq, ldsL, tid, lane, wave););
    PHASE(4, phase4(pq, (char*)lds); __syncthreads(); sample_attn_units(pq, ldsL, tid););
    if (IN(5) && IN(6)) { for (int rep_ = 0; rep_ <= ((REP_MASK >> 5) & 1); ++rep_) { if (rep_) GSYNC(); { PV ssd_passA(pq, ldsL, tid, lane, wave); } GSYNC(); { PV ssd_scan(pq, tid); } } }
    else { if (IN(5)) { PV ssd_passA(pq, ldsL, tid, lane, wave); } if (IN(6)) { PV ssd_scan(pq, tid); } }
    SEAM(6);
    PHASE(7, ssd_passC(pq, ldsL, tid, lane, wave); sample_ssd4_units(pq, ldsL, tid, lane, wave););
    PHASE(9, small_gemm<2>(WSP(bf16_t, WS_H) + (size_t)SEQ * DM, WSP(bf16_t, WS_WTOUT), DM, DM, WSP(bf16_t, WS_MF) + (size_t)SEQ * DM, DM, ldsL, tid, lane, wave);
        pg8::Gemm g{WSP(pg8::bf16_t, WS_H), WSP(pg8::bf16_t, WS_WTOUT), SEQ, DM, DM}; pg8::StaticOrder S; S.init(SEQ, DM, gridDim.x, blockIdx.x); pg8::EpiBf E{WSP(pg8::bf16_t, WS_MF), DM};
        pg8::gemm_phase<pg8::EpiBf, pg8::StaticOrder, true, true>(ldsL, g, S, E););
    PHASE(10, phase8(pq, lane, gw, ngw););
    PHASE(11, small_gemm<1>(WSP(bf16_t, WS_H) + (size_t)SEQ * DM, WSP(bf16_t, WS_WTUP), DFF, DM, WSP(bf16_t, WS_HID) + (size_t)SEQ * DFF, DFF, ldsL, tid, lane, wave);
        pg8::Gemm g{WSP(pg8::bf16_t, WS_H), WSP(pg8::bf16_t, WS_WTUP), SEQ, DFF, DM}; pg8::StaticOrder S; S.init(SEQ, DFF, gridDim.x, blockIdx.x); pg8::EpiRelu2 E{WSP(pg8::bf16_t, WS_HID), DFF};
        pg8::gemm_phase<pg8::EpiRelu2, pg8::StaticOrder, true, true>(ldsL, g, S, E););
    PHASE(12, small_gemm<2>(WSP(bf16_t, WS_HID) + (size_t)SEQ * DFF, WSP(bf16_t, WS_WTDN), DM, DFF, WSP(bf16_t, WS_MF) + (size_t)SEQ * DM, DM, ldsL, tid, lane, wave);
        pg8::Gemm g{WSP(pg8::bf16_t, WS_HID), WSP(pg8::bf16_t, WS_WTDN), SEQ, DM, DFF}; pg8::StaticOrder S; S.init(SEQ, DM, gridDim.x, blockIdx.x); pg8::EpiBf E{WSP(pg8::bf16_t, WS_MF), DM};
        pg8::gemm_phase<pg8::EpiBf, pg8::StaticOrder, true, true>(ldsL, g, S, E););
    if (IN(13)) { PV phase11(pq, lane, gw, ngw); }
#undef IN
#undef SEAM
}

#ifndef MK_PER_PHASE
#define MK_PER_PHASE 0
#endif
extern "C" void kernel_launch(void* const* d_in, const int* in_sizes, int n_in, void* d_out, int out_size, void* d_ws, size_t ws_size, hipStream_t stream) {
    static int grid = 0;
    if (grid == 0) {
        if (n_in != 26 || out_size != (int)O_END || ws_size < WS_END) { fprintf(stderr, "kernel_launch: unexpected shapes n_in %d out %d ws %zu (need %zu)\n", n_in, out_size, ws_size, (size_t)WS_END); grid = -1; return; }
        int dev = 0, cus = 0, per_cu = 0;
        (void)hipGetDevice(&dev);
        if (hipDeviceGetAttribute(&cus, hipDeviceAttributeMultiprocessorCount, dev) != hipSuccess || cus <= 0) cus = 256;
        if (hipFuncSetAttribute((const void*)fox_ssd_fwd, hipFuncAttributeMaxDynamicSharedMemorySize, LDS_BYTES) != hipSuccess) fprintf(stderr, "kernel_launch: hipFuncSetAttribute failed\n");
        if (hipOccupancyMaxActiveBlocksPerMultiprocessor(&per_cu, (const void*)fox_ssd_fwd, NTHR, LDS_BYTES) != hipSuccess || per_cu < 1) { fprintf(stderr, "kernel_launch: occupancy query says %d\n", per_cu); per_cu = 1; }
        (void)hipGetLastError();
        grid = cus * per_cu;
    }
    if (grid < 0) return;
    if (hipMemsetAsync((char*)d_ws + WS_BAR, 0, 16384, stream) != hipSuccess) { fprintf(stderr, "kernel_launch: memset of barrier words failed\n"); return; }
    Params p{};
    for (int i = 0; i < 26; ++i) p.in[i] = (const float*)d_in[i];
    p.out = (float*)d_out; p.ws = (unsigned char*)d_ws;
#if MK_PER_PHASE
    for (int k = 0; k < NPHASE; ++k) { p.ph_lo = k; p.ph_hi = k + 1; hipLaunchKernelGGL(fox_ssd_fwd, dim3(grid), dim3(NTHR), LDS_BYTES, stream, p); }
#else
    p.ph_lo = 0; p.ph_hi = NPHASE;
    void* args[] = {&p};
    hipError_t e = hipLaunchCooperativeKernel((const void*)fox_ssd_fwd, dim3(grid), dim3(NTHR), args, LDS_BYTES, stream);
    if (e != hipSuccess) fprintf(stderr, "kernel_launch: cooperative launch failed: %s (grid %d)\n", hipGetErrorString(e), grid);
#endif
}
```

```cpp
#include <hip/hip_runtime.h>
#include <hip/hip_bf16.h>
#include <hip/hip_cooperative_groups.h>
#include <cstdio>
#include <cstdint>
namespace cg = cooperative_groups;

namespace pg8 {
#define PG8_LAS __attribute__((address_space(3)))
typedef unsigned short bf16_t;
typedef short bf16x8 __attribute__((ext_vector_type(8)));
typedef float f32x4 __attribute__((ext_vector_type(4)));
typedef unsigned u32x4 __attribute__((ext_vector_type(4)));
constexpr int BM = 256, BK = 64, HALF = 128, HTB = HALF * BK * 2  , STAGE_BYTES = 8 * HTB, NXCD = 8, WGM = 8;

__host__ __device__ __forceinline__ int lds_byte(int r, int c) { const int st = (r >> 4) * 2 + (c >> 5), rr = r & 15, cc = c & 31, ob = rr * 64 + cc * 2; return st * 1024 + (ob ^ (((ob >> 9) & 1) << 5)); }
__host__ __device__ __forceinline__ void stage_rc(int b, int& R, int& C) { const int st = b / 1024, sb = b % 1024, swz = sb ^ (((sb >> 9) & 1) << 5); R = (st >> 1) * 16 + swz / 64; C = (st & 1) * 32 + (swz % 64) / 2; }
__host__ __device__ __forceinline__ int perm32(int rho) { const int n = rho >> 4, i = rho & 15; return 8 * (i >> 2) + 4 * n + (i & 3); }

struct Unit { int pm, pn; };
struct Gemm { const bf16_t* A; const bf16_t* Bt; int M, N, K; };

struct StaticOrder {
    int nM, nN, nwg, G, c;
    __host__ __device__ void init(int M, int N, int G_, int c_) { nM = M / BM; nN = N / BM; nwg = nM * nN; G = G_; c = c_; }
    __host__ __device__ bool next(int i, Unit& u) const {
        const long L = (long)i * G + c; if (L >= nwg) return false;
        int wgid = (int)L; { const int q = nwg / NXCD, r = nwg % NXCD, xcd = wgid % NXCD, off = wgid / NXCD; wgid = (xcd < r ? xcd * (q + 1) : r * (q + 1) + (xcd - r) * q) + off; }
        const int nig = WGM * nN, gid = wgid / nig, fm = gid * WGM, gsz = (nM - fm) < WGM ? (nM - fm) : WGM;
        u.pm = fm + ((wgid % nig) % gsz); u.pn = (wgid % nig) / gsz; return true;
    }
    __device__ __forceinline__ void a_ready(const Unit&) const {}
    __device__ __forceinline__ void done(const Unit&) const {}
};

__device__ __forceinline__ unsigned cvt_pk_bf16(float lo, float hi) { unsigned r; asm volatile("v_cvt_pk_bf16_f32 %0, %1, %2" : "=v"(r) : "v"(lo), "v"(hi)); return r; }
template <class Epi, class Sched, bool ALIGN_EPI = false, bool SP2 = false>
__device__ __forceinline__ void gemm_phase(PG8_LAS unsigned char* lds, const Gemm g, const Sched& S, const Epi& E) {
    const int tid = threadIdx.x, wid = __builtin_amdgcn_readfirstlane(tid >> 6), lane = tid & 63, wr = wid >> 2, wc = wid & 3, fr = lane & 15, fq = lane >> 4;
    const int K = g.K, nt = K / BK;
    unsigned voffA[2], voffB[2];
#pragma unroll
    for (int i = 0; i < 2; ++i) { int R, C; stage_rc(tid * 16 + i * 8192, R, C); const int Rb = Epi::PERM ? ((R & ~31) + perm32(R & 31)) : R;
        voffA[i] = (unsigned)(R * K + C) * 2u; voffB[i] = (unsigned)(Rb * K + C) * 2u; }
    const size_t kstep = (size_t)(BK * 2);
    const size_t hstep = (size_t)HALF * K * 2;
    const size_t tstep = 2 * hstep;
    const unsigned ldsw = (unsigned)wid * 1024u;
    const int aoff = lds_byte(wr * 64 + fr, fq * 8), boff = lds_byte(wc * 32 + fr, fq * 8);
#define PG8_SA(b, h) (((b) * 2 + (h)) * HTB)
#define PG8_SB(b, h) ((4 + (b) * 2 + (h)) * HTB)
#define PG8_STAGE(bufoff, gbase, voff) do { _Pragma("unroll") for (int _i = 0; _i < 2; ++_i) \
        __builtin_amdgcn_global_load_lds((const unsigned*)((const char*)(gbase) + (voff)[_i]), (PG8_LAS unsigned*)(lds + (bufoff) + ldsw + _i * 8192), 16, 0, 0); } while (0)
#define PG8_LDA(dst, b, h) do { _Pragma("unroll") for (int m = 0; m < 4; ++m) _Pragma("unroll") for (int k = 0; k < 2; ++k) dst[m][k] = *(const PG8_LAS bf16x8*)(lds + PG8_SA(b, h) + aoff + m * 2048 + k * 1024); } while (0)
#define PG8_LDB(dst, b, h) do { _Pragma("unroll") for (int n = 0; n < 2; ++n) _Pragma("unroll") for (int k = 0; k < 2; ++k) dst[n][k] = *(const PG8_LAS bf16x8*)(lds + PG8_SB(b, h) + boff + n * 2048 + k * 1024); } while (0)
#define PG8_MMA(ai, bj, At, Bt) do { __builtin_amdgcn_s_setprio(1); _Pragma("unroll") for (int m = 0; m < 4; ++m) _Pragma("unroll") for (int n = 0; n < 2; ++n) _Pragma("unroll") for (int k = 0; k < 2; ++k) \
        acc[ai][bj][m][n] = __builtin_amdgcn_mfma_f32_16x16x32_bf16(Bt[n][k], At[m][k], acc[ai][bj][m][n], 0, 0, 0); __builtin_amdgcn_s_setprio(0); } while (0)
#define PG8_WAIT_V(n) asm volatile("s_waitcnt vmcnt(" #n ")" ::: "memory")
#define PG8_WAIT_L(n) asm volatile("s_waitcnt lgkmcnt(" #n ")" ::: "memory")
#define PG8_BAR __builtin_amdgcn_s_barrier()
#define PG8_SCHED __builtin_amdgcn_sched_barrier(0)
    Unit cur, nxt; int ui = 0;
    if (!S.next(0, cur)) return;
    f32x4 acc[2][2][4][2];
#pragma unroll
    for (int a = 0; a < 2; ++a)
#pragma unroll
        for (int b = 0; b < 2; ++b)
#pragma unroll
            for (int m = 0; m < 4; ++m)
#pragma unroll
                for (int n = 0; n < 2; ++n) acc[a][b][m][n] = (f32x4){0.f, 0.f, 0.f, 0.f};
    bf16x8 At[4][2], B0[2][2], B1[2][2];
    const char* cA = (const char*)g.A + (size_t)cur.pm * tstep; const char* cB = (const char*)g.Bt + (size_t)cur.pn * tstep;
    S.a_ready(cur);
    if constexpr (SP2) {
        PG8_STAGE(PG8_SB(0, 0), cB, voffB); PG8_STAGE(PG8_SB(0, 1), cB + hstep, voffB); PG8_STAGE(PG8_SA(0, 0), cA, voffA); PG8_STAGE(PG8_SA(0, 1), cA + hstep, voffA);
        if (wr == 1) PG8_BAR;
        PG8_WAIT_V(2); PG8_BAR;
        PG8_STAGE(PG8_SB(1, 0), cB + kstep, voffB); PG8_STAGE(PG8_SA(1, 0), cA + kstep, voffA); PG8_STAGE(PG8_SB(1, 1), cB + hstep + kstep, voffB);
        PG8_WAIT_V(6); PG8_BAR;
    } else {
        PG8_STAGE(PG8_SB(0, 0), cB, voffB); PG8_STAGE(PG8_SA(0, 0), cA, voffA); PG8_STAGE(PG8_SB(0, 1), cB + hstep, voffB); PG8_STAGE(PG8_SA(0, 1), cA + hstep, voffA);
        if (wr == 1) PG8_BAR;
        PG8_WAIT_V(4); PG8_BAR;
        PG8_STAGE(PG8_SB(1, 0), cB + kstep, voffB); PG8_STAGE(PG8_SA(1, 0), cA + kstep, voffA); PG8_STAGE(PG8_SB(1, 1), cB + hstep + kstep, voffB);
        PG8_WAIT_V(6); PG8_BAR;
    }
    for (;;) {
        const bool has_next = S.next(ui + 1, nxt);
        const char* nA = has_next ? (const char*)g.A + (size_t)nxt.pm * tstep : cA; const char* nB = has_next ? (const char*)g.Bt + (size_t)nxt.pn * tstep : cB;
        for (int t = 0; t < nt; t += 2) {
            const bool last = (t == nt - 2);
            const char* a1 = cA + (size_t)(t + 1) * kstep;
            const char* a2 = last ? nA : cA + (size_t)(t + 2) * kstep; const char* b2 = last ? nB : cB + (size_t)(t + 2) * kstep;
            const char* a3 = a2 + kstep; const char* b3 = b2 + kstep;
            if (last && has_next) S.a_ready(nxt);
            if constexpr (SP2) {
            PG8_LDB(B0, 0, 0); PG8_LDB(B1, 0, 1); PG8_SCHED; PG8_LDA(At, 0, 0); PG8_STAGE(PG8_SA(1, 1), a1 + hstep, voffA);
            PG8_WAIT_V(8); PG8_WAIT_L(0); PG8_BAR; PG8_MMA(0, 0, At, B0); PG8_MMA(0, 1, At, B1); PG8_BAR; PG8_SCHED;
            PG8_LDA(At, 0, 1); PG8_STAGE(PG8_SB(0, 0), b2, voffB); PG8_STAGE(PG8_SB(0, 1), b2 + hstep, voffB); PG8_STAGE(PG8_SA(0, 0), a2, voffA);
            PG8_WAIT_V(8); PG8_WAIT_L(0); PG8_BAR; PG8_MMA(1, 0, At, B0); PG8_MMA(1, 1, At, B1); PG8_BAR; PG8_SCHED;
            PG8_LDB(B0, 1, 0); PG8_LDB(B1, 1, 1); PG8_SCHED; PG8_LDA(At, 1, 0); PG8_STAGE(PG8_SA(0, 1), a2 + hstep, voffA);
            PG8_WAIT_V(8); PG8_WAIT_L(0); PG8_BAR; PG8_MMA(0, 0, At, B0); PG8_MMA(0, 1, At, B1); PG8_BAR; PG8_SCHED;
            PG8_LDA(At, 1, 1); PG8_STAGE(PG8_SB(1, 0), b3, voffB); PG8_STAGE(PG8_SB(1, 1), b3 + hstep, voffB); PG8_STAGE(PG8_SA(1, 0), a3, voffA);
            PG8_WAIT_V(8); PG8_WAIT_L(0); PG8_BAR; PG8_MMA(1, 0, At, B0); PG8_MMA(1, 1, At, B1); PG8_BAR; PG8_SCHED;
            } else {
            PG8_LDB(B0, 0, 0); PG8_SCHED; PG8_LDA(At, 0, 0); PG8_STAGE(PG8_SA(1, 1), a1 + hstep, voffA);
            PG8_WAIT_L(8); PG8_BAR; PG8_WAIT_L(0); PG8_MMA(0, 0, At, B0); PG8_BAR; PG8_SCHED;
            PG8_LDB(B1, 0, 1); PG8_STAGE(PG8_SB(0, 0), b2, voffB);
            PG8_BAR; PG8_WAIT_L(0); PG8_MMA(0, 1, At, B1); PG8_BAR;
            PG8_LDA(At, 0, 1); PG8_STAGE(PG8_SA(0, 0), a2, voffA);
            PG8_BAR; PG8_WAIT_L(0); PG8_MMA(1, 0, At, B0); PG8_BAR; PG8_SCHED;
            PG8_STAGE(PG8_SB(0, 1), b2 + hstep, voffB);
            PG8_WAIT_V(6); PG8_BAR; PG8_MMA(1, 1, At, B1); PG8_BAR;
            PG8_LDB(B0, 1, 0); PG8_SCHED; PG8_LDA(At, 1, 0); PG8_STAGE(PG8_SA(0, 1), a2 + hstep, voffA);
            PG8_WAIT_L(8); PG8_BAR; PG8_WAIT_L(0); PG8_MMA(0, 0, At, B0); PG8_BAR; PG8_SCHED;
            PG8_LDB(B1, 1, 1); PG8_STAGE(PG8_SB(1, 0), b3, voffB);
            PG8_BAR; PG8_WAIT_L(0); PG8_MMA(0, 1, At, B1); PG8_BAR;
            PG8_LDA(At, 1, 1); PG8_STAGE(PG8_SA(1, 0), a3, voffA);
            PG8_BAR; PG8_WAIT_L(0); PG8_MMA(1, 0, At, B0); PG8_BAR; PG8_SCHED;
            PG8_STAGE(PG8_SB(1, 1), b3 + hstep, voffB);
            PG8_WAIT_V(6); PG8_BAR; PG8_MMA(1, 1, At, B1); PG8_BAR;
            }
        }
        if constexpr (ALIGN_EPI) { if (wr == 0) PG8_BAR; }
        if constexpr (!Epi::AFTER_DRAIN) { E(acc, cur, wr, wc, fr, fq); S.done(cur); }
        if (!has_next) break;
#pragma unroll
        for (int a = 0; a < 2; ++a)
#pragma unroll
            for (int b = 0; b < 2; ++b)
#pragma unroll
                for (int m = 0; m < 4; ++m)
#pragma unroll
                    for (int n = 0; n < 2; ++n) acc[a][b][m][n] = (f32x4){0.f, 0.f, 0.f, 0.f};
        cur = nxt; cA = nA; cB = nB; ++ui;
        if constexpr (ALIGN_EPI) { if (wr == 1) PG8_BAR; }
    }
    PG8_WAIT_V(0);
    if constexpr (!ALIGN_EPI) { if (wr == 0) PG8_BAR; }
    PG8_BAR;
    if constexpr (Epi::AFTER_DRAIN) { E.fused(acc, cur, wr, wc, fr, fq, lds, wid, lane); S.done(cur); }
#undef PG8_SA
#undef PG8_SB
#undef PG8_STAGE
#undef PG8_LDA
#undef PG8_LDB
#undef PG8_MMA
#undef PG8_WAIT_V
#undef PG8_WAIT_L
#undef PG8_BAR
#undef PG8_SCHED
}
}

constexpr int DM = 1024, SEQ = 16384, NSB = 16, NSL = 16, PAST = 1024, NSR = NSB * NSL  , R = SEQ + NSR  ;
constexpr int NH = 8, HD = 128, SH = 16, SP = 64, SG = 4, SN = 128, CONVD = 2048, DFF = 4096;
constexpr int NIN = 8448;
constexpr int TKS = PAST + NSL;
constexpr float EPS = 1e-6f;
constexpr float FOX_SCALE = 0.08838834764831845f, INV_SCALE = 11.313708498984761f;
constexpr size_t O_YP = 0, O_YS = O_YP + (size_t)SEQ * DM, O_PK = O_YS + (size_t)NSR * DM, O_PV = O_PK + (size_t)SEQ * DM, O_PL = O_PV + (size_t)SEQ * DM,
                 O_PC = O_PL + (size_t)SEQ * NH, O_PS = O_PC + 3 * CONVD, O_SK = O_PS + (size_t)SH * SP * SN, O_SV = O_SK + (size_t)NSR * DM, O_SL = O_SV + (size_t)NSR * DM,
                 O_SC = O_SL + (size_t)NSR * NH, O_SS = O_SC + (size_t)NSB * 3 * CONVD, O_END = O_SS + (size_t)NSB * SH * SP * SN;
static_assert(O_END == 53583872, "output size");
constexpr size_t WS_WTIN = 0, WS_WTOUT = WS_WTIN + (size_t)NIN * DM * 2, WS_WTUP = WS_WTOUT + (size_t)DM * DM * 2, WS_WTDN = WS_WTUP + (size_t)DFF * DM * 2,
                 WS_MOD = WS_WTDN + (size_t)DM * DFF * 2, WS_LOGF = WS_MOD + 17 * 6144 * 4, WS_DT = WS_LOGF + (size_t)R * 8 * 4, WS_FSP = WS_DT + (size_t)R * 16 * 4,
                 WS_FSS = WS_FSP + (size_t)NH * SEQ * 4, WS_GAS = WS_FSS + (size_t)128 * TKS * 4, WS_GBS = WS_GAS + (size_t)NSR * DM * 2, WS_H = WS_GBS + (size_t)NSR * DM * 2,
                 WS_Q = WS_H + (size_t)R * DM * 2, WS_K = WS_Q + (size_t)R * DM * 2, WS_V = WS_K + (size_t)R * DM * 2, WS_Z = WS_V + (size_t)R * DM * 2,
                 WS_XBC = WS_Z + (size_t)R * DM * 2, WS_CDEC = WS_XBC + (size_t)R * CONVD * 2, WS_NRM = WS_CDEC + 256 * 16 * 4, WS_BAR = WS_NRM + 256, WS_GQ = WS_BAR + 16384, WS_GD = WS_GQ + (size_t)NH * SEQ * 4, WS_LOGFT = WS_GD + (size_t)NH * SEQ * 4, WS_END = WS_LOGFT + (size_t)NH * SEQ * 4;
constexpr size_t WS_ST = WS_K;
static_assert((size_t)256 * 16 * 64 * 128 * 2 <= WS_Z - WS_K, "state overlay");
constexpr size_t WS_YS = WS_Q;
constexpr size_t WS_HID = WS_Q;
constexpr size_t WS_MF = WS_XBC;
static_assert(WS_MOD % 256 == 0 && WS_H % 256 == 0 && WS_FSS % 256 == 0 && WS_GAS % 256 == 0, "align");
constexpr int LDS_BYTES = 147456;
constexpr int NTHR = 512, NWV = 8;

#define LAS __attribute__((address_space(3)))
typedef unsigned short bf16_t;
typedef float f32x4 __attribute__((ext_vector_type(4)));
typedef unsigned u32x4 __attribute__((ext_vector_type(4)));
typedef unsigned u32x2 __attribute__((ext_vector_type(2)));
typedef short bf16x8 __attribute__((ext_vector_type(8)));

__device__ __forceinline__ unsigned pk2(float lo, float hi) { return pg8::cvt_pk_bf16(lo, hi); }
__device__ __forceinline__ float bf2f(unsigned short b) { return __uint_as_float(((unsigned)b) << 16); }
__device__ __forceinline__ float bflo(unsigned w) { return __uint_as_float(w << 16); }
__device__ __forceinline__ float bfhi(unsigned w) { return __uint_as_float(w & 0xffff0000u); }
__device__ __forceinline__ float wave_sum(float v) {
#pragma unroll
    for (int o = 1; o < 64; o <<= 1) v += __shfl_xor(v, o);
    return v;
}
__device__ __forceinline__ float sigmoidf_(float x) { return __builtin_amdgcn_rcpf(1.f + __expf(-x)); }
__device__ __forceinline__ float siluf_(float x) { return x * __builtin_amdgcn_rcpf(1.f + __expf(-x)); }
__device__ __forceinline__ float softplusf_(float x) { return fmaxf(x, 0.f) + __logf(1.f + __expf(-fabsf(x))); }
__device__ __forceinline__ float logsigmoidf_(float x) { return fminf(x, 0.f) - __logf(1.f + __expf(-fabsf(x))); }

struct Params { const float* in[26]; float* out; unsigned char* ws; int ph_lo, ph_hi; };
typedef const __attribute__((address_space(4))) Params* PP;
__device__ __forceinline__ PP kparams() { PP q = (PP)__builtin_amdgcn_kernarg_segment_ptr(); asm volatile("" : "+s"(q)); return q; }
__device__ __forceinline__ bool in_phase(int k) { PP q = kparams(); return q->ph_lo <= k && k < q->ph_hi; }
__device__ __forceinline__ int launder_tid() { int t = threadIdx.x; asm volatile("" : "+v"(t)); return t; }
enum { I_XP = 0, I_XS, I_CP, I_CS, I_CK, I_CV, I_CLF, I_SCONV, I_SSM, I_WADA, I_BADA, I_GPM, I_GQM, I_GPF, I_GQF, I_WIN, I_BF, I_CW, I_CB, I_DTB, I_ALOG, I_DSKIP, I_SNG, I_WOUT, I_WUP, I_WDN };

namespace pg8 {
struct EpiIn {
    static constexpr bool PERM = true, AFTER_DRAIN = false;
    int dummy;
    __device__ __forceinline__ void operator()(const f32x4 (&acc)[2][2][4][2], const Unit& u, int wr, int wc, int fr, int fq) const {
        const int pn = u.pn;
        const int seg = pn < 16 ? (pn >> 2) : (pn < 24 ? 4 : (pn < 28 ? 5 : (pn < 32 ? 6 : 7)));
        switch (seg) {
            case 0: body<0>(acc, u, wr, wc, fr, fq); break; case 1: body<1>(acc, u, wr, wc, fr, fq); break; case 2: body<2>(acc, u, wr, wc, fr, fq); break; case 3: body<3>(acc, u, wr, wc, fr, fq); break;
            case 4: body<4>(acc, u, wr, wc, fr, fq); break; case 5: body<5>(acc, u, wr, wc, fr, fq); break; case 6: body<6>(acc, u, wr, wc, fr, fq); break; default: body<7>(acc, u, wr, wc, fr, fq); break; }
    }
    template <int seg>
    __device__ __forceinline__ void body(const f32x4 (&acc)[2][2][4][2], const Unit& u, int wr, int wc, int fr, int fq) const {
        PP pq = kparams(); unsigned char* ws = pq->ws; float* out = pq->out; const float* b_f = pq->in[I_BF]; const float* dt_bias = pq->in[I_DTB];
        const int pn = u.pn;
        constexpr int segbase = seg < 4 ? seg * 1024 : (seg == 4 ? 4096 : (seg == 5 ? 6144 : (seg == 6 ? 7168 : 8192)));
#pragma unroll
        for (int ai = 0; ai < 2; ++ai)
#pragma unroll
            for (int m = 0; m < 4; ++m) {
                const int row = u.pm * BM + ai * HALF + wr * 64 + m * 16 + fr;
                const bool smp = row >= SEQ; const int srow = row - SEQ;
#pragma unroll
                for (int bj = 0; bj < 2; ++bj) {
                    const int c = pn * BM + bj * HALF + wc * 32 + 8 * fq - segbase;
                    const f32x4 v0 = acc[ai][bj][m][0], v1 = acc[ai][bj][m][1];
                    u32x4 w; w.x = cvt_pk_bf16(v0[0], v0[1]); w.y = cvt_pk_bf16(v0[2], v0[3]); w.z = cvt_pk_bf16(v1[0], v1[1]); w.w = cvt_pk_bf16(v1[2], v1[3]);
                    if (seg == 0) { *(u32x4*)((bf16_t*)(ws + WS_Q) + (size_t)row * DM + c) = w; }
                    else if (seg == 1 || seg == 2) {
                        *(u32x4*)((bf16_t*)(ws + (seg == 1 ? WS_K : WS_V)) + (size_t)row * DM + c) = w;
                        float* o = smp ? out + (seg == 1 ? O_SK : O_SV) + (size_t)srow * DM + c : out + (seg == 1 ? O_PK : O_PV) + (size_t)row * DM + c;
                        *(f32x4*)o = v0; *(f32x4*)(o + 4) = v1;
                    }
                    else if (seg == 3) { *(u32x4*)((bf16_t*)(ws + WS_Z) + (size_t)row * DM + c) = w; }
                    else if (seg == 4) {
                        *(u32x4*)((bf16_t*)(ws + WS_XBC) + (size_t)row * CONVD + c) = w;
                        if (!smp) { if (row >= SEQ - 3) { float* o = out + O_PC + (size_t)(row - (SEQ - 3)) * CONVD + c; *(f32x4*)o = v0; *(f32x4*)(o + 4) = v1; } }
                        else { const int i = srow & 15, b = srow >> 4; if (i >= 13) { float* o = out + O_SC + (size_t)(b * 3 + i - 13) * CONVD + c; *(f32x4*)o = v0; *(f32x4*)(o + 4) = v1; } }
                    }
                    else if (seg == 5 || seg == 6) {
                        bf16_t* d = smp ? (bf16_t*)(ws + (seg == 5 ? WS_GAS : WS_GBS)) + (size_t)srow * DM + c
                                        : (bf16_t*)(out + O_YP) + (seg == 5 ? (size_t)0 : (size_t)SEQ * DM) + (size_t)row * DM + c;
                        *(u32x4*)d = w;
                    }
                    else {
                        if (c == 0) {
                            float lf[8];
#pragma unroll
                            for (int j = 0; j < 4; ++j) { lf[j] = logsigmoidf_(v0[j] + b_f[j]); lf[4 + j] = logsigmoidf_(v1[j] + b_f[4 + j]); }
                            float* o1 = (float*)(ws + WS_LOGF) + (size_t)row * 8; float* o2 = smp ? out + O_SL + (size_t)srow * 8 : out + O_PL + (size_t)row * 8;
                            *(f32x4*)o1 = (f32x4){lf[0], lf[1], lf[2], lf[3]}; *(f32x4*)(o1 + 4) = (f32x4){lf[4], lf[5], lf[6], lf[7]};
                            *(f32x4*)o2 = (f32x4){lf[0], lf[1], lf[2], lf[3]}; *(f32x4*)(o2 + 4) = (f32x4){lf[4], lf[5], lf[6], lf[7]};
                            if (!smp) { float* ot = (float*)(ws + WS_LOGFT) + row;
#pragma unroll
                                for (int j = 0; j < 8; ++j) ot[(size_t)j * SEQ] = lf[j]; }
                        } else if (c == 8 || c == 16) {
                            float d[8];
#pragma unroll
                            for (int j = 0; j < 4; ++j) { d[j] = softplusf_(v0[j] + dt_bias[c - 8 + j]); d[4 + j] = softplusf_(v1[j] + dt_bias[c - 8 + 4 + j]); }
                            float* o1 = (float*)(ws + WS_DT) + (size_t)row * 16 + (c - 8);
                            *(f32x4*)o1 = (f32x4){d[0], d[1], d[2], d[3]}; *(f32x4*)(o1 + 4) = (f32x4){d[4], d[5], d[6], d[7]};
                        }
                    }
                }
            }
    }
};
struct EpiF32 {
    static constexpr bool PERM = false, AFTER_DRAIN = false;
    float* O; int ldc;
    __device__ __forceinline__ void operator()(const f32x4 (&acc)[2][2][4][2], const Unit& u, int wr, int wc, int fr, int fq) const {
#pragma unroll
        for (int ai = 0; ai < 2; ++ai)
#pragma unroll
            for (int m = 0; m < 4; ++m) { float* rowp = O + (size_t)(u.pm * BM + ai * HALF + wr * 64 + m * 16 + fr) * ldc + u.pn * BM + wc * 32 + 4 * fq;
#pragma unroll
                for (int bj = 0; bj < 2; ++bj)
#pragma unroll
                    for (int n = 0; n < 2; ++n) *(f32x4*)(rowp + bj * HALF + n * 16) = acc[ai][bj][m][n]; }
    }
};
struct EpiBf {
    static constexpr bool PERM = true, AFTER_DRAIN = false;
    bf16_t* O; int ldc;
    __device__ __forceinline__ void operator()(const f32x4 (&acc)[2][2][4][2], const Unit& u, int wr, int wc, int fr, int fq) const {
#pragma unroll
        for (int ai = 0; ai < 2; ++ai)
#pragma unroll
            for (int m = 0; m < 4; ++m) { bf16_t* rowp = O + (size_t)(u.pm * BM + ai * HALF + wr * 64 + m * 16 + fr) * ldc + u.pn * BM + wc * 32 + 8 * fq;
#pragma unroll
                for (int bj = 0; bj < 2; ++bj) { const f32x4 v0 = acc[ai][bj][m][0], v1 = acc[ai][bj][m][1];
                    u32x4 w; w.x = cvt_pk_bf16(v0[0], v0[1]); w.y = cvt_pk_bf16(v0[2], v0[3]); w.z = cvt_pk_bf16(v1[0], v1[1]); w.w = cvt_pk_bf16(v1[2], v1[3]);
                    *(u32x4*)(rowp + bj * HALF) = w; } }
    }
};
struct EpiRelu2 {
    static constexpr bool PERM = true, AFTER_DRAIN = false;
    bf16_t* O; int ldc;
    __device__ __forceinline__ void operator()(const f32x4 (&acc)[2][2][4][2], const Unit& u, int wr, int wc, int fr, int fq) const {
#pragma unroll
        for (int ai = 0; ai < 2; ++ai)
#pragma unroll
            for (int m = 0; m < 4; ++m) { bf16_t* rowp = O + (size_t)(u.pm * BM + ai * HALF + wr * 64 + m * 16 + fr) * ldc + u.pn * BM + wc * 32 + 8 * fq;
#pragma unroll
                for (int bj = 0; bj < 2; ++bj) { f32x4 v0 = acc[ai][bj][m][0], v1 = acc[ai][bj][m][1];
#pragma unroll
                    for (int j = 0; j < 4; ++j) { const float a = fmaxf(v0[j], 0.f), b = fmaxf(v1[j], 0.f); v0[j] = a * a; v1[j] = b * b; }
                    u32x4 w; w.x = cvt_pk_bf16(v0[0], v0[1]); w.y = cvt_pk_bf16(v0[2], v0[3]); w.z = cvt_pk_bf16(v1[0], v1[1]); w.w = cvt_pk_bf16(v1[2], v1[3]);
                    *(u32x4*)(rowp + bj * HALF) = w; } }
    }
};
}

namespace att {
constexpr int D = 128, LD = 1024;
constexpr float SCALE = 0.08838834764831845f;
constexpr float THR = 8.f;
constexpr bool WSKIP = false;
constexpr int NW = 8, QBLK = 32, KVBLK = 64, QB = NW * QBLK;
constexpr int SHM_V = KVBLK * D * 2, SHM_K = KVBLK * D * 2;
constexpr int ATT_LDS = 2 * SHM_V + 2 * SHM_K + NW * 64 * 4;
constexpr int FT_OFF = 73728;
using bf16 = __hip_bfloat16;
typedef short bf16x8 __attribute__((ext_vector_type(8)));
typedef short s16x4 __attribute__((ext_vector_type(4)));
typedef float f32x16 __attribute__((ext_vector_type(16)));
typedef float f32x4 __attribute__((ext_vector_type(4)));
typedef unsigned u32x4 __attribute__((ext_vector_type(4)));
template <class A, class Bt> struct same_t { static constexpr bool v = false; };
template <class A> struct same_t<A, A> { static constexpr bool v = true; };

#define KSWZ(row, colB) ((row) * 256 + ((colB) ^ (((row) & 7) << 4)))
#define SBAR() __builtin_amdgcn_sched_barrier(0)
__device__ __forceinline__ int v_st(int k, int c) { const int kk = (k & ~0xC) | ((k & 4) << 1) | ((k & 8) >> 1); return ((kk >> 3) * 4 + (c >> 5)) * 512 + ((kk & 7) * 32 + (c & 31)) * 2; }
__device__ __forceinline__ int v_rd_base(int lane) { return ((lane & 3) << 3) | (((lane >> 2) & 3) << 6) | (((lane >> 4) & 1) << 5) | (((lane >> 5) & 1) << 8); }
constexpr int v_rd_off(int d0, int ks, int half) { return d0 * 512 + ks * 4096 + half * 2048; }
__device__ __forceinline__ int crow(int r, int hi) { return (r & 3) + 8 * (r >> 2) + 4 * hi; }
__device__ __forceinline__ unsigned cvtpk(float lo, float hi) {
    unsigned r; asm volatile("v_cvt_pk_bf16_f32 %0, %1, %2" : "=v"(r) : "v"(lo), "v"(hi)); return r;
}
__device__ __forceinline__ bf16x8 pack8(f32x4 a, f32x4 b) {
    u32x4 w = {cvtpk(a[0], a[1]), cvtpk(a[2], a[3]), cvtpk(b[0], b[1]), cvtpk(b[2], b[3])};
    return *reinterpret_cast<bf16x8*>(&w);
}
template <class T> __device__ __forceinline__ bf16x8 load8(const T* p) {
    if constexpr (same_t<T, float>::v) { return pack8(*(const f32x4*)p, *(const f32x4*)(p + 4)); }
    else { return *reinterpret_cast<const bf16x8*>(p); }
}
__device__ __forceinline__ void mask_tile(f32x16& p0, f32x16& p1, int dq, unsigned W) {
    const float NEG = -__builtin_inff();
#pragma unroll
    for (int r = 0; r < 16; ++r) {
        const int c = (r & 3) + 8 * (r >> 2);
        if ((unsigned)(dq - c) >= W) p0[r] = NEG;
        if ((unsigned)(dq - c - 32) >= W) p1[r] = NEG;
    }
}
__device__ __forceinline__ void partialSM(f32x16& p0, f32x16& p1, float& m_reg, float& mn, float& alpha) {
    float pmax = p0[0]; for (int r = 1; r < 16; ++r) pmax = fmaxf(pmax, p0[r]); for (int r = 0; r < 16; ++r) pmax = fmaxf(pmax, p1[r]);
    { auto rr = __builtin_amdgcn_permlane32_swap(__float_as_uint(pmax), __float_as_uint(pmax), false, false);
      pmax = fmaxf(__uint_as_float(rr[0]), __uint_as_float(rr[1])); }
    constexpr float C2 = 1.4426950408889634f * SCALE;
    if (__builtin_expect(__all((pmax - m_reg) * SCALE <= THR), 1)) { mn = m_reg; alpha = 1.f; }
    else { mn = fmaxf(m_reg, pmax); alpha = __builtin_amdgcn_exp2f((m_reg - mn) * C2); m_reg = mn; }
    const float mnL = -mn * C2;
    for (int r = 0; r < 16; ++r) p0[r] = fmaf(p0[r], C2, mnL); for (int r = 0; r < 16; ++r) p1[r] = fmaf(p1[r], C2, mnL);
    for (int r = 0; r < 16; ++r) p0[r] = __builtin_amdgcn_exp2f(p0[r]);
}
__device__ __forceinline__ void finishSM(f32x16& p0, f32x16& p1, float alpha, float& l_reg, bf16x8& pa0, bf16x8& pa1, bf16x8& pa2, bf16x8& pa3) {
    for (int r = 0; r < 16; ++r) p1[r] = __builtin_amdgcn_exp2f(p1[r]);
    float ps = 0; for (int r = 0; r < 16; ++r) ps += p0[r]; for (int r = 0; r < 16; ++r) ps += p1[r];
    { auto rr = __builtin_amdgcn_permlane32_swap(__float_as_uint(ps), __float_as_uint(ps), false, false);
      ps = __uint_as_float(rr[0]) + __uint_as_float(rr[1]); }
    l_reg = l_reg * alpha + ps;
#define PK4(P, B_, OUT) do { unsigned a0 = cvtpk(P[B_+0], P[B_+1]), a1 = cvtpk(P[B_+2], P[B_+3]);                          \
        unsigned b0 = cvtpk(P[B_+4], P[B_+5]), b1 = cvtpk(P[B_+6], P[B_+7]);                                             \
        auto r0 = __builtin_amdgcn_permlane32_swap(a0, b0, false, false); auto r1 = __builtin_amdgcn_permlane32_swap(a1, b1, false, false); \
        u32x4 w = {r0[0], r1[0], r0[1], r1[1]}; OUT = *reinterpret_cast<bf16x8*>(&w); } while (0)
    PK4(p0, 0, pa0); PK4(p0, 8, pa1); PK4(p1, 0, pa2); PK4(p1, 8, pa3);
#undef PK4
}
template <int KB, bool SK>
__device__ __forceinline__ void qkt(f32x16& p0, f32x16& p1, const char* K_lds, int r32, int hi, const bf16x8* qr, bool act, const float* FTk) {
    if (SK && !act) { const float NEG = -__builtin_inff();
#pragma unroll
        for (int r = 0; r < 16; ++r) { p0[r] = NEG; p1[r] = NEG; } return; }
    { const f32x4* fb = (const f32x4*)FTk + hi;
#pragma unroll
      for (int i = 0; i < 4; ++i) { const f32x4 f0 = fb[2 * i], f1 = fb[8 + 2 * i];
#pragma unroll
        for (int j = 0; j < 4; ++j) { p0[4 * i + j] = f0[j]; p1[4 * i + j] = f1[j]; } } }
    const char* kb[4];
#pragma unroll
    for (int dd = 0; dd < 4; ++dd) kb[dd] = K_lds + KB * SHM_K + KSWZ(r32, (dd * 16 + hi * 8) * 2);
#pragma unroll
    for (int d0 = 0; d0 < 8; ++d0) { const char* a = kb[d0 & 3] + (d0 >> 2) * 128;
        bf16x8 b0 = *reinterpret_cast<const bf16x8*>(a);
        bf16x8 b1 = *reinterpret_cast<const bf16x8*>(a + 32 * 256);
        p0 = __builtin_amdgcn_mfma_f32_32x32x16_bf16(b0, qr[d0], p0, 0, 0, 0);
        p1 = __builtin_amdgcn_mfma_f32_32x32x16_bf16(b1, qr[d0], p1, 0, 0, 0); }
}
template <int VB, bool SK>
__device__ __forceinline__ void pv_tile(f32x16* o, int vb0, bf16x8 pa0, bf16x8 pa1, bf16x8 pa2, bf16x8 pa3, bool act) {
    if (SK && !act) return;
#define TRRD(dst, off) asm volatile("ds_read_b64_tr_b16 %0, %1 offset:%2" : "=&v"(dst) : "v"(vb0), "i"(off) : "memory")
#define PV_D0(d0) do { s16x4 l0, l1, l2, l3, h0, h1, h2, h3; constexpr int b_ = VB * SHM_V + v_rd_off(d0, 0, 0);     \
        TRRD(l0, b_); TRRD(h0, b_ + 2048); TRRD(l1, b_ + 4096); TRRD(h1, b_ + 6144); TRRD(l2, b_ + 8192); TRRD(h2, b_ + 10240); TRRD(l3, b_ + 12288); TRRD(h3, b_ + 14336); \
        asm volatile("s_waitcnt lgkmcnt(0)" ::: "memory"); SBAR();                 \
        o[d0] = __builtin_amdgcn_mfma_f32_32x32x16_bf16(pa0, (bf16x8){l0[0], l0[1], l0[2], l0[3], h0[0], h0[1], h0[2], h0[3]}, o[d0], 0, 0, 0);   \
        o[d0] = __builtin_amdgcn_mfma_f32_32x32x16_bf16(pa1, (bf16x8){l1[0], l1[1], l1[2], l1[3], h1[0], h1[1], h1[2], h1[3]}, o[d0], 0, 0, 0);   \
        o[d0] = __builtin_amdgcn_mfma_f32_32x32x16_bf16(pa2, (bf16x8){l2[0], l2[1], l2[2], l2[3], h2[0], h2[1], h2[2], h2[3]}, o[d0], 0, 0, 0);   \
        o[d0] = __builtin_amdgcn_mfma_f32_32x32x16_bf16(pa3, (bf16x8){l3[0], l3[1], l3[2], l3[3], h3[0], h3[1], h3[2], h3[3]}, o[d0], 0, 0, 0); } while (0)
    PV_D0(0); PV_D0(1); PV_D0(2); PV_D0(3);
#undef PV_D0
#undef TRRD
}

template <class TIn, class TOut> struct BlockRef { const TIn* Q; const TIn* K; const TIn* V; TOut* O; const float* F; int P0; int jlo; };
template <class TIn> struct Seam {
    bf16x8 qr[8];
    bf16x8 st_v0, st_v1, st_k0, st_k1; f32x4 sf0, sf1, sf2, sf3;
    f32x4 tq[16];
};
__device__ __forceinline__ int swa_jlo(int P0, int W) { const int lowk = P0 - W + 1; return lowk > 0 ? lowk / KVBLK : 0; }
#define ROW(p, k0, rr) ((p) + (size_t)(k0) * LD + (unsigned)((rr) * LD + sc))
#define VMW() asm volatile("s_waitcnt vmcnt(0)" ::: "memory")
#define VMWN(n) asm volatile("s_waitcnt vmcnt(%0)" :: "i"(n) : "memory")
#define SLOAD_H(Kp, Vp, Fp, k0) do { S.st_v0 = load8<TIn>(ROW(Vp, k0, sr)); S.st_v1 = load8<TIn>(ROW(Vp, k0, 32 + sr));              \
                         S.st_k0 = load8<TIn>(ROW(Kp, k0, sr)); S.st_k1 = load8<TIn>(ROW(Kp, k0, 32 + sr)); } while (0)
#define SWRITE_HK(bf) do { *(bf16x8*)(K_lds + (bf) * SHM_K + kws) = S.st_k0; *(bf16x8*)(K_lds + (bf) * SHM_K + kws + 32 * 256) = S.st_k1; } while (0)
#define SWRITE_HV(bf) do { *(bf16x8*)(V_lds + (bf) * SHM_V + vst0) = S.st_v0; *(bf16x8*)(V_lds + (bf) * SHM_V + vst1) = S.st_v1; } while (0)
#define SWRITE_H(bf) do { SWRITE_HV(bf); SWRITE_HK(bf); } while (0)
#define SLOAD_F(p, k0) do { S.sf0 = *(const f32x4*)ROW(p, k0, sr); S.sf1 = *(const f32x4*)(ROW(p, k0, sr) + 4);                \
                            S.sf2 = *(const f32x4*)ROW(p, k0, 32 + sr); S.sf3 = *(const f32x4*)(ROW(p, k0, 32 + sr) + 4); } while (0)
#define SWRITE_KF(bf) do { *(bf16x8*)(K_lds + (bf) * SHM_K + kws) = pack8(S.sf0, S.sf1); *(bf16x8*)(K_lds + (bf) * SHM_K + kws + 32 * 256) = pack8(S.sf2, S.sf3); } while (0)
#define SWRITE_VF(bf) do { *(bf16x8*)(V_lds + (bf) * SHM_V + vst0) = pack8(S.sf0, S.sf1); *(bf16x8*)(V_lds + (bf) * SHM_V + vst1) = pack8(S.sf2, S.sf3); } while (0)
template <class TIn, class TOut>
__device__ __forceinline__ void causal_swa_prime(const BlockRef<TIn, TOut>& cur, int W, char* lds, Seam<TIn>& S) {
    constexpr bool F32 = same_t<TIn, float>::v;
    const int tid = threadIdx.x, wid = __builtin_amdgcn_readfirstlane(tid >> 6), lane = tid & 63, r32 = lane & 31, hi = lane >> 5;
    const int sr = tid >> 4, sc = (tid & 15) * 8, kws = KSWZ(sr, sc * 2); char* K_lds = lds + 2 * SHM_V;
    const int kb0 = cur.jlo * KVBLK;
    for (int d0 = 0; d0 < 8; ++d0) S.qr[d0] = load8<TIn>(cur.Q + (size_t)(wid * QBLK + r32) * LD + d0 * 16 + hi * 8);
    if constexpr (F32) { SLOAD_F((const float*)cur.K, kb0); VMW(); SWRITE_KF(0); SBAR(); SLOAD_F((const float*)cur.V, kb0); }
    else { SLOAD_H(cur.K, cur.V, cur.F, kb0); VMW(); SWRITE_HK(0); }
    __syncthreads();
}
template <class TIn, class TOut>
__device__ __forceinline__ void causal_swa_block(const BlockRef<TIn, TOut>& cur, const BlockRef<TIn, TOut>& nxt, int skv, int W, char* lds, Seam<TIn>& S) {
    constexpr bool F32 = same_t<TIn, float>::v;
    const int tid = threadIdx.x, wid = __builtin_amdgcn_readfirstlane(tid >> 6), lane = tid & 63, r32 = lane & 31, hi = lane >> 5;
    const int j_lo = cur.jlo;
    int j_hi = (cur.P0 + QB - 1) / KVBLK + 1; if (j_hi > skv / KVBLK) j_hi = skv / KVBLK;
    const int NT = j_hi - j_lo;
    const int kbn = nxt.jlo * KVBLK;
    const int qlo = cur.P0 + wid * QBLK, qm = qlo + r32 - 4 * hi;
    char* V_lds = lds; char* K_lds = lds + 2 * SHM_V;
    float* ws = (float*)(lds + 2 * SHM_V + 2 * SHM_K) + wid * 64; float* li_l = ws, * al_l = ws + 32; const float* FT = (const float*)(lds + FT_OFF);
    const float* Fh = cur.F;
    float m_reg = -1e30f, l_reg = 0; f32x16 o[4] = {};
    const int sr = tid >> 4, sc = (tid & 15) * 8, vst0 = v_st(sr, sc), vst1 = v_st(32 + sr, sc), kws = KSWZ(sr, sc * 2);
    const int vb0 = (int)(uintptr_t)V_lds + v_rd_base(lane);
    const TIn* Kh = cur.K; const TIn* Vh = cur.V;
#define RESC(a) do { if (__any((a) < 1.f)) { if (hi == 0) al_l[r32] = (a); asm volatile("s_waitcnt lgkmcnt(0)" ::: "memory");              \
                     for (int d_ = 0; d_ < 4; ++d_) for (int r = 0; r < 16; ++r) o[d_][r] *= al_l[crow(r, hi)]; } } while (0)
#define KBASE(t) ((j_lo + (t)) * KVBLK)
#define ACT(t) (KBASE(t) <= qlo + QBLK - 1 && KBASE(t) + KVBLK - 1 >= qlo - W + 1)
#define MASKT(P0_, P1_, t) do { const int kb_ = KBASE(t); if ((!SK || ACT(t)) && (kb_ + KVBLK - 1 > qlo || kb_ <= qlo + QBLK - 1 - W)) mask_tile(P0_, P1_, qm - kb_, (unsigned)W); } while (0)
    constexpr int NQL = F32 ? 16 : 8;
    constexpr bool SK = WSKIP && !F32;
#define SEAM_K0() do { VMWN(NQL); if constexpr (F32) { SWRITE_KF(0); SBAR(); SLOAD_F((const float*)nxt.V, kbn); } else { SWRITE_HK(0); } SBAR(); } while (0)
    f32x16 pA0, pA1, pB0, pB1; float mnA, mnB, alA, alB; bf16x8 pa0, pa1, pa2, pa3;
    if constexpr (F32) { VMW(); SWRITE_VF(0); SBAR(); } else { SWRITE_HV(0); SBAR(); }
    if (NT > 1) { if constexpr (F32) SLOAD_F((const float*)Kh, KBASE(1)); else SLOAD_H(Kh, Vh, Fh, KBASE(1)); }
    SBAR(); qkt<0, SK>(pA0, pA1, K_lds, r32, hi, S.qr, ACT(0), FT + KBASE(0));
    if constexpr (F32) { if (NT > 1) { VMW(); SWRITE_KF(1); SBAR(); SLOAD_F((const float*)Vh, KBASE(1)); } }
    MASKT(pA0, pA1, 0); partialSM(pA0, pA1, m_reg, mnA, alA);
    if (NT > 1) { VMW(); if constexpr (F32) { SWRITE_VF(1); SBAR(); if (NT > 2) SLOAD_F((const float*)Kh, KBASE(2)); } else SWRITE_H(1); }
    __syncthreads();
#define HALF_STEP(PX0, PX1, mnX, alX, PY0, PY1, alY, t, KB, VB, SB) do {                                                      \
        SBAR(); qkt<KB, SK>(PX0, PX1, K_lds, r32, hi, S.qr, ACT(t), FT + KBASE(t));                                             \
        finishSM(PY0, PY1, alY, l_reg, pa0, pa1, pa2, pa3); SBAR();                                                           \
        if ((t) + 1 < NT) { if constexpr (F32) { VMW(); SWRITE_KF(SB); SBAR(); SLOAD_F((const float*)Vh, KBASE((t) + 1)); }  \
                            else { SLOAD_H(Kh, Vh, Fh, KBASE((t) + 1)); } SBAR(); }                                               \
        pv_tile<VB, SK>(o, vb0, pa0, pa1, pa2, pa3, ACT((t) - 1)); MASKT(PX0, PX1, (t)); partialSM(PX0, PX1, m_reg, mnX, alX);                                        \
        __syncthreads();                                                                                                      \
        if ((t) + 1 < NT) { VMW(); if constexpr (F32) { SWRITE_VF(SB); SBAR(); if ((t) + 2 < NT) SLOAD_F((const float*)Kh, KBASE((t) + 2)); } \
                            else { SWRITE_H(SB); } }                                                                          \
        RESC(alX); __syncthreads(); } while (0)
    for (int t = 1; t + 1 < NT; t += 2) {
        HALF_STEP(pB0, pB1, mnB, alB, pA0, pA1, alA, t, 1, 0, 0);
        HALF_STEP(pA0, pA1, mnA, alA, pB0, pB1, alB, t + 1, 0, 1, 1);
    }
    const bool even = (NT & 1) == 0;
    if (even) { SBAR(); qkt<1, SK>(pB0, pB1, K_lds, r32, hi, S.qr, ACT(NT - 1), FT + KBASE(NT - 1)); SBAR(); }
#define QROW(e) (nxt.Q + (size_t)(wid * QBLK + r32) * LD + ((e) >> 1) * 16 + hi * 8 + ((e) & 1) * 4)
    if constexpr (F32) { SLOAD_F((const float*)nxt.K, kbn); SBAR();
#pragma unroll
        for (int e = 0; e < 8; ++e) S.tq[e] = *(const f32x4*)QROW(e); }
    else { SLOAD_H(nxt.K, nxt.V, nxt.F, kbn); SBAR();
#pragma unroll
        for (int d0 = 0; d0 < 8; ++d0) S.qr[d0] = load8<TIn>(nxt.Q + (size_t)(wid * QBLK + r32) * LD + d0 * 16 + hi * 8); }
    SBAR();
    finishSM(pA0, pA1, alA, l_reg, pa0, pa1, pa2, pa3); SBAR();
    if constexpr (F32) {
#pragma unroll
        for (int e = 8; e < 16; ++e) S.tq[e] = *(const f32x4*)QROW(e); SBAR(); }
#undef QROW
    pv_tile<0, SK>(o, vb0, pa0, pa1, pa2, pa3, ACT(even ? NT - 2 : NT - 1));
    if (even) { MASKT(pB0, pB1, NT - 1); partialSM(pB0, pB1, m_reg, mnB, alB); __syncthreads(); RESC(alB);
        finishSM(pB0, pB1, alB, l_reg, pa0, pa1, pa2, pa3); SBAR(); pv_tile<1, SK>(o, vb0, pa0, pa1, pa2, pa3, ACT(NT - 1)); }
    SBAR(); SEAM_K0();
    if (hi == 0) li_l[r32] = l_reg; asm volatile("s_waitcnt lgkmcnt(0)" ::: "memory");
    float rli[16];
#pragma unroll
    for (int r = 0; r < 16; ++r) rli[r] = __builtin_amdgcn_rcpf(li_l[crow(r, hi)]);
    TOut* Ow = cur.O + (size_t)(wid * QBLK) * LD;
#pragma unroll
    for (int r = 0; r < 16; ++r) { const int orow = crow(r, hi);
#pragma unroll
        for (int d0 = 0; d0 < 4; ++d0) { const float v = o[d0][r] * rli[r];
            if constexpr (same_t<TOut, float>::v) { Ow[(size_t)orow * LD + d0 * 32 + r32] = v; }
            else { const float vn = __shfl_xor(v, 1);
                   if ((r32 & 1) == 0) *(unsigned*)(Ow + (size_t)orow * LD + d0 * 32 + r32) = cvtpk(v, vn); } } }
    if constexpr (F32) {
#pragma unroll
        for (int d0 = 0; d0 < 8; ++d0) S.qr[d0] = pack8(S.tq[2 * d0], S.tq[2 * d0 + 1]); }
    __syncthreads();
#undef RESC
#undef KBASE
#undef ACT
#undef MASKT
#undef SEAM_K0
#undef HALF_STEP
}
#undef ROW
#undef VMW
#undef VMWN
#undef SLOAD_H
#undef SWRITE_HK
#undef SWRITE_HV
#undef SWRITE_H
#undef SLOAD_F
#undef SWRITE_KF
#undef SWRITE_VF
}

#define XB_TMO      128
#define XB_XCNT(j)  (256  + 64 * (j))
#define XB_XSUB(j)  (1280 + 64 * (j))
#define XB_XGEN(j)  (2304 + 64 * (j))
#define XB_TOP      3328
#define XB_TOPGEN   3392
#define XCD_BAR_WORDS 3456
#define XB_SPIN_CAP (1u << 18)

__device__ __forceinline__ unsigned xb_ld(unsigned* p)              { return __hip_atomic_load(p, __ATOMIC_RELAXED, __HIP_MEMORY_SCOPE_AGENT); }
__device__ __forceinline__ unsigned xb_add(unsigned* p, unsigned v) { return __hip_atomic_fetch_add(p, v, __ATOMIC_RELAXED, __HIP_MEMORY_SCOPE_AGENT); }
__device__ __forceinline__ unsigned xb_xcc_id() { return (unsigned)__builtin_amdgcn_s_getreg((3 << 11) | 20) & 0xFu; }
#define XB_SPIN(cond, bar) do { unsigned _sp = 0; while (cond) { __builtin_amdgcn_s_sleep(1); \
    if ((++_sp & 255u) == 0u) { if (xb_ld(&(bar)[XB_TMO])) break; if (_sp > XB_SPIN_CAP) { atomicAdd(&(bar)[XB_TMO], 1u); break; } } } } while (0)

struct XcdBarrier {
    unsigned* bar; unsigned x;
    volatile LAS unsigned* st;
};

__device__ __forceinline__ XcdBarrier xcd_barrier_post(unsigned* bar, volatile LAS unsigned* st) {
    XcdBarrier b; b.bar = bar; b.x = xb_xcc_id(); b.st = st;
    if (threadIdx.x == 0) (void)xb_add(&bar[XB_XCNT(b.x)], 1u);
    return b;
}
__device__ __forceinline__ void xcd_barrier_complete(unsigned* bar, unsigned x, unsigned& nloc, unsigned& nx) {
    const unsigned G = gridDim.x * gridDim.y * gridDim.z;
    unsigned sum, cnt, mine, sp = 0u;
    for (;;) {
        sum = 0u; cnt = 0u; mine = 0u;
#pragma unroll
        for (unsigned j = 0; j < 16; ++j) { const unsigned c = xb_ld(&bar[XB_XCNT(j)]); sum += c; cnt += (c > 0u) ? 1u : 0u; mine = (j == x) ? c : mine; }
        if (sum == G) break;
        __builtin_amdgcn_s_sleep(1);
        if ((++sp & 255u) == 0u) { if (xb_ld(&bar[XB_TMO])) break; if (sp > XB_SPIN_CAP) { atomicAdd(&bar[XB_TMO], 1u); break; } }
    }
    nloc = mine > 0u ? mine : 1u; nx = cnt > 0u ? cnt : 1u;
}

__device__ __forceinline__ void xcd_barrier(const XcdBarrier& b) {
    asm volatile("s_waitcnt vmcnt(0)" ::: "memory");
    __syncthreads();
    if (threadIdx.x == 0) {
        unsigned* bar = b.bar;
        __builtin_amdgcn_s_waitcnt(0);
        unsigned nloc = b.st[0], nx = b.st[1];
        if (nloc == 0u) { xcd_barrier_complete(bar, b.x, nloc, nx); b.st[0] = nloc; b.st[1] = nx; }
        const unsigned old = xb_add(&bar[XB_XSUB(b.x)], 1u);
        const unsigned gen = old / nloc;
        if (old + 1u == (gen + 1u) * nloc) {
            __builtin_amdgcn_fence(__ATOMIC_RELEASE, "agent");
            asm volatile("s_waitcnt vmcnt(0)" ::: "memory");
            const unsigned og = xb_add(&bar[XB_TOP], 1u);
            const unsigned tg = og / nx;
            if (og + 1u == (tg + 1u) * nx) xb_add(&bar[XB_TOPGEN], 1u);
            else XB_SPIN(xb_ld(&bar[XB_TOPGEN]) == tg, bar);
            __builtin_amdgcn_fence(__ATOMIC_ACQUIRE, "agent");
            xb_add(&bar[XB_XGEN(b.x)], 1u);
            asm volatile("s_waitcnt vmcnt(0)" ::: "memory");
        } else {
            XB_SPIN(xb_ld(&bar[XB_XGEN(b.x)]) == gen, bar);
            __builtin_amdgcn_fence(__ATOMIC_ACQUIRE, "agent");
            asm volatile("s_waitcnt vmcnt(0)" ::: "memory");
        }
    }
    __syncthreads();
}

typedef float f32x2_t __attribute__((ext_vector_type(2))); typedef __bf16 bf16x2_t __attribute__((ext_vector_type(2)));
__device__ __forceinline__ unsigned cvtpk_c(float lo, float hi) { f32x2_t v = {lo, hi}; bf16x2_t b = __builtin_convertvector(v, bf16x2_t); return __builtin_bit_cast(unsigned, b); }

#define WSP(T, off) ((T*)(pq->ws + (off)))
__device__ __forceinline__ unsigned short f2bf1(float v) { return (unsigned short)(pk2(v, 0.f) & 0xffffu); }

__device__ __forceinline__ int in_srccol(int n) {
    if (n < 3072) return n;
    if (n < 6144) return n + 8;
    if (n < 8192) return n + 24;
    if (n < 8200) return 3072 + (n - 8192);
    if (n < 8216) return 6152 + (n - 8200);
    return -1;
}
template <bool MAPIN>
__device__ __forceinline__ void transpose_item(const float* __restrict__ W, int K, int Nsrc, int Ndst, bf16_t* __restrict__ WT, LAS float* scr, int item, int lane) {
    const int nblk = Ndst / 32, kb = item / nblk, nb = item % nblk, k0 = 64 * kb, n0 = 32 * nb;
    const int n = n0 + (lane & 31); const int sc = MAPIN ? in_srccol(n) : n;
#pragma unroll 16
    for (int i = 0; i < 32; ++i) { const int kk = 2 * i + (lane >> 5); scr[kk * 33 + (lane & 31)] = sc >= 0 ? W[(size_t)(k0 + kk) * Nsrc + sc] : 0.f; }
    const int c = lane & 7;
#pragma unroll
    for (int j = 0; j < 4; ++j) { const int n_ = (lane >> 3) + 8 * j; const LAS float* s = scr + (8 * c) * 33 + n_;
        u32x4 o; o.x = pk2(s[0 * 33], s[1 * 33]); o.y = pk2(s[2 * 33], s[3 * 33]); o.z = pk2(s[4 * 33], s[5 * 33]); o.w = pk2(s[6 * 33], s[7 * 33]);
        *(u32x4*)(WT + (size_t)(n0 + n_) * K + k0 + 8 * c) = o; }
}
__device__ __forceinline__ void phase0(PP pq, LAS unsigned char* lds, int tid, int lane, int wave) {
    if (blockIdx.x == 0 && tid < 32) WSP(unsigned, WS_NRM)[tid] = 0u;
    {
        LAS float* SC = (LAS float*)lds; LAS float* PR = (LAS float*)(lds + 17 * 1024 * 4);
        const float* cp = pq->in[I_CP]; const float* cs = pq->in[I_CS];
        for (int i = tid; i < 17 * 1024; i += NTHR) { const int r = i >> 10, k = i & 1023; const float c = r == 0 ? cp[k] : cs[(r - 1) * 1024 + k]; SC[i] = siluf_(c); }
        __syncthreads();
        const float* wada = pq->in[I_WADA]; const float* bada = pq->in[I_BADA]; float* mod = WSP(float, WS_MOD);
        for (int cb = blockIdx.x; cb < 256; cb += gridDim.x) {
            const int kq = tid >> 3, cq = tid & 7, col = cb * 24 + cq * 3;
            float acc[17][3];
#pragma unroll
            for (int r = 0; r < 17; ++r) { acc[r][0] = 0.f; acc[r][1] = 0.f; acc[r][2] = 0.f; }
#pragma unroll 4
            for (int kk = 0; kk < 16; ++kk) { const int k = kq + 64 * kk; const float* wr = wada + (size_t)k * 6144 + col; const float w0 = wr[0], w1 = wr[1], w2 = wr[2];
#pragma unroll
                for (int r = 0; r < 17; ++r) { const float s = SC[r * 1024 + k]; acc[r][0] += s * w0; acc[r][1] += s * w1; acc[r][2] += s * w2; } }
#pragma unroll
            for (int r = 0; r < 17; ++r)
#pragma unroll
                for (int j = 0; j < 3; ++j) { float a = acc[r][j]; a += __shfl_xor(a, 8); a += __shfl_xor(a, 16); a += __shfl_xor(a, 32); acc[r][j] = a; }
            if ((lane >> 3) == 0) {
#pragma unroll
                for (int r = 0; r < 17; ++r)
#pragma unroll
                    for (int j = 0; j < 3; ++j) PR[wave * 408 + r * 24 + cq * 3 + j] = acc[r][j];
            }
            __syncthreads();
            if (tid < 408) { const int r = tid / 24, cc = tid % 24; float s = 0.f;
#pragma unroll
                for (int w = 0; w < 8; ++w) s += PR[w * 408 + tid];
                mod[r * 6144 + cb * 24 + cc] = s + bada[cb * 24 + cc]; }
            __syncthreads();
        }
    }
    {
        LAS float* scr = (LAS float*)(lds + wave * 16384);
        const int gw = blockIdx.x * NWV + wave, ngw = gridDim.x * NWV;
        constexpr int I_IN = (DM / 64) * (NIN / 32);
        (void)scr; (void)gw; (void)ngw; (void)I_IN;
        { LAS float* T = (LAS float*)lds; const float* W = pq->in[I_WIN]; bf16_t* WT = WSP(bf16_t, WS_WTIN);
          const int kk = tid >> 5, c8 = (tid & 31) * 8, nn = tid >> 1, kh = (tid & 1) * 8;
          f32x4 pa = (f32x4){0.f, 0.f, 0.f, 0.f}, pb = pa;
          { const int it0 = blockIdx.x; if (it0 < 64 * 33) { const int kb = it0 / 33, nb = it0 - kb * 33; if (nb < 32) { const float* src = W + (size_t)(16 * kb + kk) * 8216 + in_srccol(256 * nb) + c8; pa = *(const f32x4*)src; pb = *(const f32x4*)(src + 4); } } }
          for (int it = blockIdx.x; it < 64 * 33; it += gridDim.x) { const int kb = it / 33, nb = it - kb * 33, k0 = 16 * kb, n0 = 256 * nb;
              __syncthreads();
              if (nb < 32) { *(LAS f32x4*)(T + kk * 260 + c8) = pa; *(LAS f32x4*)(T + kk * 260 + c8 + 4) = pb;
                  }
              else {
#pragma unroll
                  for (int e = 0; e < 8; ++e) { const int sc = in_srccol(n0 + c8 + e); T[kk * 260 + c8 + e] = sc >= 0 ? W[(size_t)(k0 + kk) * 8216 + sc] : 0.f; } }
              { const int itn = it + gridDim.x; if (itn < 64 * 33) { const int kbn = itn / 33, nbn = itn - kbn * 33; if (nbn < 32) { const float* src = W + (size_t)(16 * kbn + kk) * 8216 + in_srccol(256 * nbn) + c8; pa = *(const f32x4*)src; pb = *(const f32x4*)(src + 4); } } }
              __syncthreads();
              u32x4 o; o.x = pk2(T[(kh + 0) * 260 + nn], T[(kh + 1) * 260 + nn]); o.y = pk2(T[(kh + 2) * 260 + nn], T[(kh + 3) * 260 + nn]);
              o.z = pk2(T[(kh + 4) * 260 + nn], T[(kh + 5) * 260 + nn]); o.w = pk2(T[(kh + 6) * 260 + nn], T[(kh + 7) * 260 + nn]);
              *(u32x4*)(WT + (size_t)(n0 + nn) * DM + k0 + kh) = o; }
          __syncthreads(); }
    }
}
__device__ __forceinline__ void block_transpose(const float* __restrict__ W, int K, int N, bf16_t* __restrict__ WT, LAS unsigned char* lds, int tid, int first, int nw) {
    LAS float* T = (LAS float*)lds; const int nnb = N / 256, nitems = (K / 16) * nnb;
    const int kk = tid >> 5, c8 = (tid & 31) * 8, nn = tid >> 1, kh = (tid & 1) * 8;
    for (int it = first; it < nitems; it += nw) { const int kb = it / nnb, nb = it - kb * nnb, k0 = 16 * kb, n0 = 256 * nb;
        __syncthreads();
        { const float* src = W + (size_t)(k0 + kk) * N + n0 + c8; const f32x4 a = *(const f32x4*)src, b = *(const f32x4*)(src + 4); *(LAS f32x4*)(T + kk * 260 + c8) = a; *(LAS f32x4*)(T + kk * 260 + c8 + 4) = b; }
        __syncthreads();
        u32x4 o; o.x = pk2(T[(kh + 0) * 260 + nn], T[(kh + 1) * 260 + nn]); o.y = pk2(T[(kh + 2) * 260 + nn], T[(kh + 3) * 260 + nn]);
        o.z = pk2(T[(kh + 4) * 260 + nn], T[(kh + 5) * 260 + nn]); o.w = pk2(T[(kh + 6) * 260 + nn], T[(kh + 7) * 260 + nn]);
        *(u32x4*)(WT + (size_t)(n0 + nn) * K + k0 + kh) = o; }
    __syncthreads();
}
__device__ __forceinline__ void late_transposes(PP pq, LAS unsigned char* lds, int tid, int first, int nw) {
    block_transpose(pq->in[I_WOUT], DM, DM, WSP(bf16_t, WS_WTOUT), lds, tid, first, nw);
    block_transpose(pq->in[I_WUP], DM, DFF, WSP(bf16_t, WS_WTUP), lds, tid, first, nw);
    block_transpose(pq->in[I_WDN], DFF, DM, WSP(bf16_t, WS_WTDN), lds, tid, first, nw);
}

__device__ __forceinline__ const float* xrow_ptr(PP pq, int row) { return row < SEQ ? pq->in[I_XP] + (size_t)row * DM : pq->in[I_XS] + (size_t)(row - SEQ) * DM; }
__device__ __forceinline__ float* yrow_ptr(PP pq, int row) { return row < SEQ ? pq->out + O_YP + (size_t)row * DM : pq->out + O_YS + (size_t)(row - SEQ) * DM; }
__device__ __forceinline__ int modrow(int row) { return row < SEQ ? 0 : 1 + ((row - SEQ) >> 4); }
__device__ __forceinline__ float sumsq4(const f32x4 (&v)[4]) { float s = 0.f;
#pragma unroll
    for (int j = 0; j < 4; ++j) s += (v[j].x * v[j].x + v[j].y * v[j].y) + (v[j].z * v[j].z + v[j].w * v[j].w);
    return s; }
__device__ __forceinline__ void modnorm_store(const f32x4 (&v)[4], float rstd, const float* g, const float* sc, const float* sh, bf16_t* orow, int lane) {
#pragma unroll
    for (int j = 0; j < 4; ++j) { const int c = 4 * lane + 256 * j; const f32x4 gg = *(const f32x4*)(g + c), s1 = *(const f32x4*)(sc + c), s0 = *(const f32x4*)(sh + c);
        const f32x4 o = v[j] * rstd * gg * (s1 + 1.f) + s0; u32x2 w; w.x = pk2(o.x, o.y); w.y = pk2(o.z, o.w); *(u32x2*)(orow + c) = w; }
}
__device__ __forceinline__ void phase1(PP pq, int lane, int gw, int ngw) {
    const float* mod = WSP(float, WS_MOD); bf16_t* H = WSP(bf16_t, WS_H);
    for (int row = gw; row < R; row += 2 * ngw) {
        const int r1 = row + ngw; const bool has1 = r1 < R; const int rb = has1 ? r1 : row;
        const f32x4* xa = (const f32x4*)xrow_ptr(pq, row) + lane; const f32x4* xb = (const f32x4*)xrow_ptr(pq, rb) + lane; f32x4 va[4], vb[4];
#pragma unroll
        for (int j = 0; j < 4; ++j) { va[j] = __builtin_nontemporal_load(xa + 64 * j); vb[j] = __builtin_nontemporal_load(xb + 64 * j); }
        const float ra = 1.f / sqrtf(wave_sum(sumsq4(va)) * (1.f / DM) + EPS), rbs = 1.f / sqrtf(wave_sum(sumsq4(vb)) * (1.f / DM) + EPS);
        const float* ma = mod + (size_t)modrow(row) * 6144; const float* mb = mod + (size_t)modrow(rb) * 6144;
        modnorm_store(va, ra, pq->in[I_GPM], ma + 1024, ma, H + (size_t)row * DM, lane);
        if (has1) modnorm_store(vb, rbs, pq->in[I_GPM], mb + 1024, mb, H + (size_t)rb * DM, lane);
    }
}

__device__ __forceinline__ void unpack16(const bf16_t* ptr, float (&f)[16]) {
    const u32x4 a = *(const u32x4*)ptr, b = *(const u32x4*)(ptr + 8);
    f[0] = bflo(a.x); f[1] = bfhi(a.x); f[2] = bflo(a.y); f[3] = bfhi(a.y); f[4] = bflo(a.z); f[5] = bfhi(a.z); f[6] = bflo(a.w); f[7] = bfhi(a.w);
    f[8] = bflo(b.x); f[9] = bfhi(b.x); f[10] = bflo(b.y); f[11] = bfhi(b.y); f[12] = bflo(b.z); f[13] = bfhi(b.z); f[14] = bflo(b.w); f[15] = bfhi(b.w);
}
__device__ __forceinline__ float block_excl_scan(float v, LAS float* sm, int lane, int wave) {
    float inc = v;
#pragma unroll
    for (int o = 1; o < 64; o <<= 1) { const float t = __shfl_up(inc, o); if (lane >= o) inc += t; }
    __syncthreads();
    if (lane == 63) sm[wave] = inc;
    __syncthreads();
    float base = 0.f;
    for (int w = 0; w < wave; ++w) base += sm[w];
    return base + inc - v;
}
__device__ __forceinline__ void phase3(PP pq, LAS unsigned char* lds, int tid, int lane, int wave) {
    {
        const bf16_t* Qb = WSP(bf16_t, WS_Q); const bf16_t* Kb = WSP(bf16_t, WS_K); float mq = 0.f, mk = 0.f;
        for (int row0 = blockIdx.x * NWV + wave; row0 < SEQ; row0 += 2 * gridDim.x * NWV) {
            const int row1 = row0 + gridDim.x * NWV; const bool has1 = row1 < SEQ; const int rr[2] = {row0, has1 ? row1 : row0};
            float a[2][16], b[2][16];
#pragma unroll
            for (int t = 0; t < 2; ++t) { unpack16(Qb + (size_t)rr[t] * DM + 16 * lane, a[t]); unpack16(Kb + (size_t)rr[t] * DM + 16 * lane, b[t]); }
#pragma unroll
            for (int t = 0; t < 2; ++t) { float sa = 0.f, sb = 0.f, sd = 0.f;
#pragma unroll
                for (int e = 0; e < 16; ++e) { sa += a[t][e] * a[t][e]; sb += b[t][e] * b[t][e]; sd += a[t][e] * b[t][e]; }
                sa += __shfl_xor(sa, 1); sa += __shfl_xor(sa, 2); sa += __shfl_xor(sa, 4); sb += __shfl_xor(sb, 1); sb += __shfl_xor(sb, 2); sb += __shfl_xor(sb, 4);
                sd += __shfl_xor(sd, 1); sd += __shfl_xor(sd, 2); sd += __shfl_xor(sd, 4);
                if ((lane & 7) == 0 && (t == 0 || has1)) { WSP(float, WS_GQ)[(size_t)(lane >> 3) * SEQ + rr[t]] = sqrtf(sa); WSP(float, WS_GD)[(size_t)(lane >> 3) * SEQ + rr[t]] = sd * FOX_SCALE; }
                mq = fmaxf(mq, sa); mk = fmaxf(mk, sb); } }
        LAS float* red = (LAS float*)(lds + 4096);
        if ((lane & 7) == 0) { red[wave * 16 + (lane >> 3)] = mq; red[wave * 16 + 8 + (lane >> 3)] = mk; }
        __syncthreads();
        if (tid < 16) { float m = red[tid];
#pragma unroll
            for (int w = 1; w < 8; ++w) m = fmaxf(m, red[w * 16 + tid]);
            atomicMax(WSP(unsigned, WS_NRM) + tid, __float_as_uint(m)); }
        __syncthreads();
    }
    LAS float* sm = (LAS float*)lds; const float* LOGF = WSP(float, WS_LOGF);
    for (int u = blockIdx.x; u < 8 + 128; u += gridDim.x) {
        if (u < 8) { const int h = u, base = tid * 32; float loc = 0.f; const f32x4* lt4 = (const f32x4*)(WSP(float, WS_LOGFT) + (size_t)h * SEQ + base); f32x4 lv[8];
#pragma unroll
            for (int j = 0; j < 8; ++j) { lv[j] = lt4[j]; loc += (lv[j].x + lv[j].y) + (lv[j].z + lv[j].w); }
            float run = block_excl_scan(loc, sm, lane, wave); f32x4* FSP4 = (f32x4*)(WSP(float, WS_FSP) + (size_t)h * SEQ + base);
#pragma unroll
            for (int j = 0; j < 8; ++j) { f32x4 o; run += lv[j].x; o.x = run * INV_SCALE; run += lv[j].y; o.y = run * INV_SCALE; run += lv[j].z; o.z = run * INV_SCALE; run += lv[j].w; o.w = run * INV_SCALE; FSP4[j] = o; }
        } else { const int bh = u - 8, b = bh >> 3, h = bh & 7, base = tid * 3; float vals[3]; float loc = 0.f;
#pragma unroll
            for (int j = 0; j < 3; ++j) { const int s = base + j; float v = 0.f;
                if (s < TKS) v = s < PAST ? pq->in[I_CLF][((size_t)b * PAST + s) * 8 + h] : LOGF[(size_t)(SEQ + b * 16 + s - PAST) * 8 + h];
                vals[j] = v; loc += v; }
            float run = block_excl_scan(loc, sm, lane, wave); float* FSS = WSP(float, WS_FSS) + (size_t)bh * TKS;
#pragma unroll
            for (int j = 0; j < 3; ++j) { run += vals[j]; if (base + j < TKS) FSS[base + j] = run; }
        }
    }
}

typedef att::BlockRef<att::bf16, att::bf16> ABlk;
__device__ __forceinline__ ABlk attn_ref(PP pq, int idx) {
    const int L = blockIdx.x + (idx >> 1) * gridDim.x, head = L >> 5, x = L & 31, qb = (idx & 1) ? 63 - x : x, P0 = qb * 256;
    ABlk r; r.Q = WSP(att::bf16, WS_Q) + (size_t)P0 * DM + head * HD; r.K = WSP(att::bf16, WS_K) + head * HD; r.V = WSP(att::bf16, WS_V) + head * HD;
    r.O = WSP(att::bf16, WS_H) + (size_t)P0 * DM + head * HD; r.F = WSP(float, WS_FSP) + (size_t)head * SEQ; r.P0 = P0;
    { const unsigned* nrm = WSP(unsigned, WS_NRM); const float U = sqrtf(__uint_as_float(nrm[head]) * __uint_as_float(nrm[8 + head])) * FOX_SCALE;
      int ln = threadIdx.x & 63; asm volatile("" : "+v"(ln));
      const float kmaxs = sqrtf(__uint_as_float(nrm[8 + head])) * FOX_SCALE; const float* gq = WSP(float, WS_GQ) + (size_t)head * SEQ + P0; const float* gd = WSP(float, WS_GD) + (size_t)head * SEQ + P0;
      float gmin = fminf(fminf(gd[ln] - gq[ln] * kmaxs, gd[ln + 64] - gq[ln + 64] * kmaxs), fminf(gd[ln + 128] - gq[ln + 128] * kmaxs, gd[ln + 192] - gq[ln + 192] * kmaxs));
#pragma unroll
      for (int o = 1; o < 64; o <<= 1) gmin = fminf(gmin, __shfl_xor(gmin, o));
      const float thrS = (fmaxf(gmin, -2.f * U) - 32.f) * INV_SCALE, f0 = r.F[P0]; const int jd = P0 >> 6; int best = jd;
#pragma unroll
      for (int k = 0; k < 4; ++k) { const int j = ln + 64 * k; const bool ok = (j <= jd) && (f0 - r.F[64 * (j <= jd ? j : jd) + 63] >= thrS);
          const unsigned long long m = __ballot(ok); if (m) { const int first = __builtin_ctzll(m) + 64 * k; best = first < best ? first : best; } }
      r.jlo = __builtin_amdgcn_readfirstlane(best); }
    return r;
}
__device__ __forceinline__ void phase4(PP pq, char* lds) {
    if ((int)blockIdx.x >= 256) return;
    const int nmine = (256 - (int)blockIdx.x + (int)gridDim.x - 1) / (int)gridDim.x, nb = 2 * nmine;
    constexpr int W = 1 << 30;
    att::Seam<att::bf16> S;
    ABlk cur = attn_ref(pq, 0);
    att::causal_swa_prime<att::bf16, att::bf16>(cur, W, lds, S);
    float* FT = (float*)(lds + att::FT_OFF);
    for (int idx = 0; idx < nb; ++idx) {
        const ABlk nxt = (idx + 1 < nb) ? attn_ref(pq, idx + 1) : cur;
        { const float fref = cur.F[cur.P0];
            int t4_ = threadIdx.x * 4; asm volatile("" : "+v"(t4_));
            for (int s0 = cur.jlo * 64 + t4_; s0 < cur.P0 + 256; s0 += NTHR * 4) { const f32x4 f = *(const f32x4*)(cur.F + s0); *(f32x4*)(FT + s0) = (f32x4){fref - f.x, fref - f.y, fref - f.z, fref - f.w}; }
            __syncthreads(); }
        att::causal_swa_block<att::bf16, att::bf16>(cur, nxt, SEQ, W, lds, S);
        cur = nxt;
    }
}

__device__ __forceinline__ void sample_attn(PP pq, LAS unsigned char* lds, int tid, int b, int h) {
    LAS float* S = (LAS float*)lds; LAS float* Ql = S + 16 * TKS; LAS float* Fl = Ql + 16 * 128; LAS float* inv = Fl + TKS;
    bf16_t* Qb = WSP(bf16_t, WS_Q); const bf16_t* Kb = WSP(bf16_t, WS_K); const bf16_t* Vb = WSP(bf16_t, WS_V);
    const float* FSS = WSP(float, WS_FSS) + (size_t)(b * 8 + h) * TKS;
    __syncthreads();
#pragma unroll 1
    for (int idx = tid; idx < 2048; idx += NTHR) { const int i = idx >> 7, d = idx & 127; Ql[idx] = bf2f(Qb[(size_t)(SEQ + b * 16 + i) * DM + h * HD + d]); }
#pragma unroll 1
    for (int idx = tid; idx < TKS; idx += NTHR) Fl[idx] = FSS[idx];
    __syncthreads();
    {
        const int lane_ = tid & 63, wave_ = tid >> 6, fr = lane_ & 15, fq = lane_ >> 4;
        bf16x8 qf[4];
#pragma unroll
        for (int ks = 0; ks < 4; ++ks) qf[ks] = *(const bf16x8*)(Qb + (size_t)(SEQ + b * 16 + fr) * DM + h * HD + 32 * ks + 8 * fq);
#pragma unroll 3
        for (int kt = wave_; kt < 65; kt += 8) {
            bf16x8 kf[4];
            if (kt < 64) { const float* kr = pq->in[I_CK] + ((size_t)(b * PAST + kt * 16 + fr) * NH + h) * HD + 8 * fq;
#pragma unroll
                for (int ks = 0; ks < 4; ++ks) { const f32x4 a = __builtin_nontemporal_load((const f32x4*)(kr + 32 * ks)), c = __builtin_nontemporal_load((const f32x4*)(kr + 32 * ks + 4));
                    const u32x4 w = (u32x4){cvtpk_c(a.x, a.y), cvtpk_c(a.z, a.w), cvtpk_c(c.x, c.y), cvtpk_c(c.z, c.w)}; kf[ks] = __builtin_bit_cast(bf16x8, w); } }
            else { const bf16_t* kr = Kb + (size_t)(SEQ + b * 16 + fr) * DM + h * HD + 8 * fq;
#pragma unroll
                for (int ks = 0; ks < 4; ++ks) kf[ks] = *(const bf16x8*)(kr + 32 * ks); }
            f32x4 acc = (f32x4){0.f, 0.f, 0.f, 0.f};
#pragma unroll
            for (int ks = 0; ks < 4; ++ks) acc = __builtin_amdgcn_mfma_f32_16x16x32_bf16(qf[ks], kf[ks], acc, 0, 0, 0);
            const int s = kt * 16 + fr; const float fs = Fl[s];
#pragma unroll
            for (int j = 0; j < 4; ++j) { const int i = 4 * fq + j; float v = acc[j] * FOX_SCALE + Fl[PAST + i] - fs; if (s > PAST + i) v = -__builtin_inff(); S[i * TKS + s] = v; }
        }
    }
    __syncthreads();
    { const int i = tid >> 5, l32 = tid & 31; float mx = -__builtin_inff();
#pragma unroll 1
        for (int s = l32; s < TKS; s += 32) mx = fmaxf(mx, S[i * TKS + s]);
#pragma unroll
        for (int o = 1; o < 32; o <<= 1) mx = fmaxf(mx, __shfl_xor(mx, o));
        float sum = 0.f;
#pragma unroll 1
        for (int s = l32; s < TKS; s += 32) { const float e = __expf(S[i * TKS + s] - mx); S[i * TKS + s] = e; sum += e; }
#pragma unroll
        for (int o = 1; o < 32; o <<= 1) sum += __shfl_xor(sum, o);
        if (l32 == 0) inv[i] = 1.f / sum; }
    __syncthreads();
    {
        const int d4 = (tid & 31) * 4, kg = tid >> 5; f32x4 o[16];
#pragma unroll
        for (int i = 0; i < 16; ++i) o[i] = (f32x4){0.f, 0.f, 0.f, 0.f};
        const float* vr = pq->in[I_CV] + ((size_t)(b * PAST) * NH + h) * HD + d4;
#pragma unroll 5
        for (int k = 0; k < 65; ++k) { const int sidx = kg * 65 + k; f32x4 v;
            if (sidx < PAST) v = __builtin_nontemporal_load((const f32x4*)(vr + (size_t)sidx * NH * HD));
            else { const u32x2 vw = *(const u32x2*)(Vb + (size_t)(SEQ + b * 16 + sidx - PAST) * DM + h * HD + d4); v = (f32x4){bflo(vw.x), bfhi(vw.x), bflo(vw.y), bfhi(vw.y)}; }
#pragma unroll
            for (int i = 0; i < 16; ++i) o[i] += v * S[i * TKS + sidx]; }
#pragma unroll
        for (int i = 0; i < 16; ++i) { o[i].x += __shfl_xor(o[i].x, 32); o[i].y += __shfl_xor(o[i].y, 32); o[i].z += __shfl_xor(o[i].z, 32); o[i].w += __shfl_xor(o[i].w, 32); }
        __syncthreads();
        if ((tid & 32) == 0) {
#pragma unroll
            for (int i = 0; i < 16; ++i) *(LAS f32x4*)(S + ((tid >> 6) * 16 + i) * 128 + d4) = o[i]; }
        __syncthreads();
        for (int idx = tid; idx < 2048; idx += NTHR) { const int i = idx >> 7, d = idx & 127; float a = 0.f;
#pragma unroll
            for (int w8 = 0; w8 < 8; ++w8) a += S[(w8 * 16 + i) * 128 + d];
            WSP(bf16_t, WS_H)[(size_t)(SEQ + b * 16 + i) * DM + h * HD + d] = f2bf1(a * inv[i]); }
    }
}

__device__ __forceinline__ void ssd_seq(PP pq, LAS unsigned char* lds, int tid, int row0, int L, int TB, int head, const float* init, float* outst, const float* convinit) {
    const bf16_t* XBC = WSP(bf16_t, WS_XBC); bf16_t* Z = WSP(bf16_t, WS_Z); const float* DT = WSP(float, WS_DT);
    LAS float* xs = (LAS float*)lds; LAS float* Bc = xs + 64 * 64; LAS float* Cc = Bc + 64 * 128; LAS float* zl = Cc + 64 * 128; LAS float* yl = zl + 64 * 64; LAS float* dtl = yl + 64 * 64;
    const int g = head >> 2, pp = tid >> 3, ns = tid & 7, n0 = ns * 16;
    const float A = -__expf(pq->in[I_ALOG][head]), Dh = pq->in[I_DSKIP][head];
    const float* cw = pq->in[I_CW]; const float* cbias = pq->in[I_CB];
    float s[16];
#pragma unroll
    for (int j = 0; j < 16; ++j) s[j] = init ? init[(size_t)(head * SP + pp) * SN + n0 + j] : 0.f;
    for (int t0 = 0; t0 < L; t0 += TB) {
        __syncthreads();
#pragma unroll 1
        for (int idx = tid; idx < TB * 320; idx += NTHR) { const int tt = idx / 320, cc = idx - tt * 320;
            const int ch = cc < 64 ? head * 64 + cc : (cc < 192 ? 1024 + g * 128 + (cc - 64) : 1536 + g * 128 + (cc - 192));
            float a = cbias[ch];
#pragma unroll
            for (int i = 0; i < 4; ++i) { const int tr = t0 + tt - 3 + i; float xv;
                if (tr >= 0) xv = bf2f(XBC[(size_t)(row0 + tr) * CONVD + ch]); else xv = convinit ? convinit[(3 + tr) * CONVD + ch] : 0.f;
                a += cw[i * CONVD + ch] * xv; }
            a = siluf_(a);
            if (cc < 64) xs[tt * 64 + cc] = a; else if (cc < 192) Bc[tt * 128 + cc - 64] = a; else Cc[tt * 128 + cc - 192] = a; }
#pragma unroll 1
        for (int idx = tid; idx < TB * 64; idx += NTHR) { const int tt = idx >> 6, c = idx & 63; zl[idx] = bf2f(Z[(size_t)(row0 + t0 + tt) * DM + head * 64 + c]); }
        if (tid < TB) dtl[tid] = DT[(size_t)(row0 + t0 + tid) * 16 + head];
        __syncthreads();
#pragma unroll 2
        for (int tt = 0; tt < TB; ++tt) {
            const float dtv = dtl[tt], dA = __expf(dtv * A), x = xs[tt * 64 + pp], xdt = x * dtv; float y = 0.f;
#pragma unroll
            for (int j4 = 0; j4 < 4; ++j4) { const f32x4 bv = *(const LAS f32x4*)(Bc + tt * 128 + n0 + 4 * j4), cv = *(const LAS f32x4*)(Cc + tt * 128 + n0 + 4 * j4);
#pragma unroll
                for (int j = 0; j < 4; ++j) { s[4 * j4 + j] = s[4 * j4 + j] * dA + xdt * bv[j]; y += cv[j] * s[4 * j4 + j]; } }
            y += __shfl_xor(y, 1); y += __shfl_xor(y, 2); y += __shfl_xor(y, 4);
            if (ns == 0) yl[tt * 64 + pp] = (y + Dh * x) * siluf_(zl[tt * 64 + pp]);
        }
        __syncthreads();
#pragma unroll 1
        for (int idx = tid; idx < TB * 64; idx += NTHR) { const int tt = idx >> 6, c = idx & 63; WSP(bf16_t, WS_YS)[(size_t)(row0 + t0 + tt) * DM + head * 64 + c] = f2bf1(yl[idx]); }
    }
#pragma unroll
    for (int j4 = 0; j4 < 4; ++j4) *(f32x4*)(outst + (size_t)(head * SP + pp) * SN + n0 + 4 * j4) = (f32x4){s[4 * j4], s[4 * j4 + 1], s[4 * j4 + 2], s[4 * j4 + 3]};
}
constexpr int SD_CN = 0, SD_BN = 17408, SD_BT = 34816, SD_XT = 53248, SD_ACS = 90112, SD_DTL = 91136, SD_WL = 92160;
constexpr int CNS = 136, XTS = 72;
typedef float f32x16 __attribute__((ext_vector_type(16)));
#define MFMA32(a, b, c) __builtin_amdgcn_mfma_f32_32x32x16_bf16((a), (b), (c), 0, 0, 0)
__device__ __forceinline__ void ssd_stage(PP pq, LAS unsigned char* lds, int tid, int lane, int wave, int row0, int ntok, int g, const float* convinit, const int mode) {
    const bf16_t* XBC = WSP(bf16_t, WS_XBC);
    const int cb = tid & 63, tg = tid >> 6;
    const int ch = cb < 32 ? g * 256 + 8 * cb : (cb < 48 ? 1024 + g * 128 + 8 * (cb - 32) : 1536 + g * 128 + 8 * (cb - 48));
    const float* cw = pq->in[I_CW]; const float* cbs = pq->in[I_CB];
    if (tg * 8 < ntok && (mode == 1 || cb < 48)) {
    float w[4][8], y[8][8];
#pragma unroll
    for (int i = 0; i < 4; ++i) { const f32x4 a = *(const f32x4*)(cw + i * CONVD + ch), b = *(const f32x4*)(cw + i * CONVD + ch + 4);
        w[i][0] = a.x; w[i][1] = a.y; w[i][2] = a.z; w[i][3] = a.w; w[i][4] = b.x; w[i][5] = b.y; w[i][6] = b.z; w[i][7] = b.w; }
    { const f32x4 a = *(const f32x4*)(cbs + ch), b = *(const f32x4*)(cbs + ch + 4);
#pragma unroll
        for (int t = 0; t < 8; ++t) { y[t][0] = a.x; y[t][1] = a.y; y[t][2] = a.z; y[t][3] = a.w; y[t][4] = b.x; y[t][5] = b.y; y[t][6] = b.z; y[t][7] = b.w; } }
#pragma unroll
    for (int k = 0; k < 11; ++k) { const int rel = 8 * tg - 3 + k; u32x4 v = (u32x4){0u, 0u, 0u, 0u};
        float x[8];
        if (rel < 0 && convinit) { const f32x4 a = *(const f32x4*)(convinit + (size_t)(3 + rel) * CONVD + ch), b = *(const f32x4*)(convinit + (size_t)(3 + rel) * CONVD + ch + 4);
            x[0] = a.x; x[1] = a.y; x[2] = a.z; x[3] = a.w; x[4] = b.x; x[5] = b.y; x[6] = b.z; x[7] = b.w; }
        else { if (row0 + rel >= 0) v = *(const u32x4*)(XBC + (size_t)(row0 + rel) * CONVD + ch);
            x[0] = bflo(v.x); x[1] = bfhi(v.x); x[2] = bflo(v.y); x[3] = bfhi(v.y); x[4] = bflo(v.z); x[5] = bfhi(v.z); x[6] = bflo(v.w); x[7] = bfhi(v.w); }
#pragma unroll
        for (int i = 0; i < 4; ++i) { const int t = k - i;
            if (t >= 0 && t < 8) {
#pragma unroll
                for (int e = 0; e < 8; ++e) y[t][e] += w[i][e] * x[e]; } } }
#pragma unroll
    for (int t = 0; t < 8; ++t)
#pragma unroll
        for (int e = 0; e < 8; ++e) y[t][e] = siluf_(y[t][e]);
    LAS bf16_t* CN = (LAS bf16_t*)(lds + SD_CN); LAS bf16_t* BN = (LAS bf16_t*)(lds + SD_BN); LAS bf16_t* BT = (LAS bf16_t*)(lds + SD_BT); LAS bf16_t* XT = (LAS bf16_t*)(lds + SD_XT);
    if (cb < 32) { const int r = cb >> 3, p0 = (cb & 7) * 8;
#pragma unroll
        for (int e = 0; e < 8; ++e) *(LAS u32x4*)(XT + (r * 64 + p0 + e) * XTS + 8 * tg) = (u32x4){cvtpk_c(y[0][e], y[1][e]), cvtpk_c(y[2][e], y[3][e]), cvtpk_c(y[4][e], y[5][e]), cvtpk_c(y[6][e], y[7][e])};
    } else if (cb < 48) { const int n0 = (cb - 32) * 8;
        if (mode == 1) {
#pragma unroll
        for (int t = 0; t < 8; ++t) *(LAS u32x4*)(BN + (8 * tg + t) * CNS + n0) = (u32x4){cvtpk_c(y[t][0], y[t][1]), cvtpk_c(y[t][2], y[t][3]), cvtpk_c(y[t][4], y[t][5]), cvtpk_c(y[t][6], y[t][7])};
        } else {
#pragma unroll
        for (int e = 0; e < 8; ++e) *(LAS u32x4*)(BT + (n0 + e) * XTS + 8 * tg) = (u32x4){cvtpk_c(y[0][e], y[1][e]), cvtpk_c(y[2][e], y[3][e]), cvtpk_c(y[4][e], y[5][e]), cvtpk_c(y[6][e], y[7][e])};
        }
    } else { const int n0 = (cb - 48) * 8;
#pragma unroll
        for (int t = 0; t < 8; ++t) *(LAS u32x4*)(CN + (8 * tg + t) * CNS + n0) = (u32x4){cvtpk_c(y[t][0], y[t][1]), cvtpk_c(y[t][2], y[t][3]), cvtpk_c(y[t][4], y[t][5]), cvtpk_c(y[t][6], y[t][7])};
    }
    }
    if (wave < 4) { const int hd = 4 * g + wave; const float A = -__expf(pq->in[I_ALOG][hd]);
        const float dtv = lane < ntok ? WSP(float, WS_DT)[(size_t)(row0 + lane) * 16 + hd] : 0.f; float acs = dtv * A;
#pragma unroll
        for (int o = 1; o < 64; o <<= 1) { const float t = __shfl_up(acs, o); if (lane >= o) acs += t; }
        const float tot = __shfl(acs, 63);
        LAS float* ACS = (LAS float*)(lds + SD_ACS); LAS float* DTL = (LAS float*)(lds + SD_DTL); LAS float* WL = (LAS float*)(lds + SD_WL);
        ACS[wave * 64 + lane] = acs; DTL[wave * 64 + lane] = dtv; WL[wave * 64 + lane] = dtv * __expf(tot - acs); }
}
__device__ __forceinline__ void unpack8(const u32x4 a, float (&f)[8]) { f[0] = bflo(a.x); f[1] = bfhi(a.x); f[2] = bflo(a.y); f[3] = bfhi(a.y); f[4] = bflo(a.z); f[5] = bfhi(a.z); f[6] = bflo(a.w); f[7] = bfhi(a.w); }
template <int NV, int RL>
__device__ __forceinline__ void merge_thread(PP pq, int row, int col, const LAS float* yl) {
    const bool smp = row >= SEQ; const size_t ro = (size_t)row * DM + col; const size_t so = (size_t)(row - SEQ) * DM + col;
    const bf16_t* Zp = WSP(bf16_t, WS_Z) + ro; bf16_t* Hp = WSP(bf16_t, WS_H) + ro;
    const bf16_t* gap = smp ? WSP(bf16_t, WS_GAS) + so : (const bf16_t*)(pq->out + O_YP) + ro;
    const bf16_t* gbp = smp ? WSP(bf16_t, WS_GBS) + so : (const bf16_t*)(pq->out + O_YP) + (size_t)SEQ * DM + ro;
    const float* sng = pq->in[I_SNG] + col;
    float y[NV][8]; float ss = 0.f;
#pragma unroll
    for (int v = 0; v < NV; ++v) { float z[8]; unpack8(*(const u32x4*)(Zp + 8 * v), z); const f32x4 y0 = *(const LAS f32x4*)(yl + 8 * v), y1 = *(const LAS f32x4*)(yl + 8 * v + 4);
#pragma unroll
        for (int e = 0; e < 8; ++e) { const float yy = (e < 4 ? y0[e & 3] : y1[e & 3]) * siluf_(z[e]); y[v][e] = yy; ss += yy * yy; } }
#pragma unroll
    for (int o = 1; o < RL; o <<= 1) ss += __shfl_xor(ss, o);
    const float rstd = 1.f / sqrtf(ss * (1.f / 256.f) + EPS);
#pragma unroll
    for (int v = 0; v < NV; ++v) { float ya[8], ga[8], gb[8]; unpack8(*(const u32x4*)(Hp + 8 * v), ya); unpack8(*(const u32x4*)(gap + 8 * v), ga); unpack8(*(const u32x4*)(gbp + 8 * v), gb);
        const f32x4 g0 = *(const f32x4*)(sng + 8 * v), g1 = *(const f32x4*)(sng + 8 * v + 4); float m[8];
#pragma unroll
        for (int e = 0; e < 8; ++e) m[e] = sigmoidf_(ga[e]) * ya[e] + sigmoidf_(gb[e]) * (y[v][e] * rstd * (e < 4 ? g0[e & 3] : g1[e & 3]));
        *(u32x4*)(Hp + 8 * v) = (u32x4){pk2(m[0], m[1]), pk2(m[2], m[3]), pk2(m[4], m[5]), pk2(m[6], m[7])}; }
}
constexpr int YLS = 260;
constexpr size_t ST_CH = (size_t)SH * SP * SN;
__device__ __forceinline__ void ssd_passA(PP pq, LAS unsigned char* lds, int tid, int lane, int wave) {
    LAS bf16_t* BT = (LAS bf16_t*)(lds + SD_BT); LAS bf16_t* XT = (LAS bf16_t*)(lds + SD_XT); LAS float* WL = (LAS float*)(lds + SD_WL); LAS float* ACS = (LAS float*)(lds + SD_ACS);
    for (int u = blockIdx.x; u < 1024; u += gridDim.x) { const int c = u >> 2, g = u & 3;
        __syncthreads(); ssd_stage(pq, lds, tid, lane, wave, 64 * c, 64, g, nullptr, 0); __syncthreads();
        const int r = wave >> 1, nh = wave & 1, hd = 4 * g + r, cl = lane & 31, hi = lane >> 5;
        f32x16 acc[2][2];
#pragma unroll
        for (int a = 0; a < 2; ++a)
#pragma unroll
            for (int b = 0; b < 2; ++b)
#pragma unroll
                for (int i = 0; i < 16; ++i) acc[a][b][i] = 0.f;
#pragma unroll
        for (int ks = 0; ks < 4; ++ks) {
            const f32x4 w0 = *(const LAS f32x4*)(WL + r * 64 + 16 * ks + 8 * hi), w1 = *(const LAS f32x4*)(WL + r * 64 + 16 * ks + 8 * hi + 4);
            bf16x8 Bf[2];
#pragma unroll
            for (int pt = 0; pt < 2; ++pt) { const u32x4 raw = *(const LAS u32x4*)(XT + (r * 64 + 32 * pt + cl) * XTS + 16 * ks + 8 * hi);
                u32x4 sc; sc.x = cvtpk_c(bflo(raw.x) * w0.x, bfhi(raw.x) * w0.y); sc.y = cvtpk_c(bflo(raw.y) * w0.z, bfhi(raw.y) * w0.w);
                sc.z = cvtpk_c(bflo(raw.z) * w1.x, bfhi(raw.z) * w1.y); sc.w = cvtpk_c(bflo(raw.w) * w1.z, bfhi(raw.w) * w1.w);
                Bf[pt] = __builtin_bit_cast(bf16x8, sc); }
#pragma unroll
            for (int nt2 = 0; nt2 < 2; ++nt2) { const bf16x8 Af = *(const LAS bf16x8*)(BT + (32 * (2 * nh + nt2) + cl) * XTS + 16 * ks + 8 * hi);
#pragma unroll
                for (int pt = 0; pt < 2; ++pt) acc[nt2][pt] = MFMA32(Af, Bf[pt], acc[nt2][pt]); }
        }
        bf16_t* ST = WSP(bf16_t, WS_ST) + (size_t)(c * 16 + hd) * (SP * SN);
#pragma unroll
        for (int nt2 = 0; nt2 < 2; ++nt2)
#pragma unroll
            for (int pt = 0; pt < 2; ++pt)
#pragma unroll
                for (int q = 0; q < 4; ++q) { const int n = 32 * (2 * nh + nt2) + 8 * q + 4 * hi, pp = 32 * pt + cl;
                    u32x2 wv; wv.x = cvtpk_c(acc[nt2][pt][4 * q], acc[nt2][pt][4 * q + 1]); wv.y = cvtpk_c(acc[nt2][pt][4 * q + 2], acc[nt2][pt][4 * q + 3]);
                    *(u32x2*)(ST + ((n >> 2) * SP + pp) * 4) = wv; }
        if (lane == 0 && nh == 0) WSP(float, WS_CDEC)[c * 16 + hd] = __expf(ACS[r * 64 + 63]);
    }
}
__device__ __forceinline__ void ssd_scan(PP pq, int tid) {
    bf16_t* ST = WSP(bf16_t, WS_ST); const float* CDEC = WSP(float, WS_CDEC);
    for (int e = blockIdx.x * NTHR + tid; e < (int)ST_CH; e += gridDim.x * NTHR) { const int hd = e >> 13; float s = 0.f;
        for (int c0 = 0; c0 < 256; c0 += 32) { float v[32], d[32];
#pragma unroll
            for (int k = 0; k < 32; ++k) { v[k] = bf2f(ST[(size_t)(c0 + k) * ST_CH + e]); d[k] = CDEC[(c0 + k) * 16 + hd]; }
#pragma unroll
            for (int k = 0; k < 32; ++k) { ST[(size_t)(c0 + k) * ST_CH + e] = f2bf1(s); s = s * d[k] + v[k]; } }
        { const int el = e & 8191, nb = el >> 8, pp = (el >> 2) & 63, j = el & 3; pq->out[O_PS + (size_t)hd * 8192 + pp * SN + 4 * nb + j] = s; } }
}
__device__ __forceinline__ void ssd_passC(PP pq, LAS unsigned char* lds, int tid, int lane, int wave) {
    LAS bf16_t* CN = (LAS bf16_t*)(lds + SD_CN); LAS bf16_t* BN = (LAS bf16_t*)(lds + SD_BN); LAS bf16_t* XT = (LAS bf16_t*)(lds + SD_XT);
    LAS float* ACS = (LAS float*)(lds + SD_ACS); LAS float* DTL = (LAS float*)(lds + SD_DTL);
    const bf16_t* Z = WSP(bf16_t, WS_Z); bf16_t* YS = WSP(bf16_t, WS_YS);
    for (int u = blockIdx.x; u < 1024; u += gridDim.x) { const int c = u >> 2, g = u & 3;
        __syncthreads(); ssd_stage(pq, lds, tid, lane, wave, 64 * c, 64, g, nullptr, 1); __syncthreads();
        const int r = wave >> 1, lt = wave & 1, hd = 4 * g + r, cl = lane & 31, hi = lane >> 5;
        const bf16_t* SPv = WSP(bf16_t, WS_ST) + (size_t)(c * 16 + hd) * (SP * SN);
        f32x16 acc[2];
#pragma unroll
        for (int b = 0; b < 2; ++b)
#pragma unroll
            for (int i = 0; i < 16; ++i) acc[b][i] = 0.f;
#pragma unroll
        for (int ks = 0; ks < 8; ++ks) { const bf16x8 Af = *(const LAS bf16x8*)(CN + (32 * lt + cl) * CNS + 16 * ks + 8 * hi);
#pragma unroll
            for (int pt = 0; pt < 2; ++pt) { const int nb0 = 4 * ks + 2 * hi, pp = 32 * pt + cl; const u32x2 lo2 = *(const u32x2*)(SPv + (nb0 * SP + pp) * 4), hi2 = *(const u32x2*)(SPv + ((nb0 + 1) * SP + pp) * 4);
                const u32x4 bw = (u32x4){lo2.x, lo2.y, hi2.x, hi2.y}; acc[pt] = MFMA32(Af, __builtin_bit_cast(bf16x8, bw), acc[pt]); } }
#pragma unroll
        for (int q = 0; q < 4; ++q) { const f32x4 a4 = *(const LAS f32x4*)(ACS + r * 64 + 32 * lt + 8 * q + 4 * hi);
#pragma unroll
            for (int j = 0; j < 4; ++j) { const float e = __expf(a4[j]); acc[0][4 * q + j] *= e; acc[1][4 * q + j] *= e; } }
        const float al = ACS[r * 64 + 32 * lt + cl];
        for (int st = 0; st <= lt; ++st) {
            f32x16 X;
#pragma unroll
            for (int i = 0; i < 16; ++i) X[i] = 0.f;
#pragma unroll
            for (int ks = 0; ks < 8; ++ks) { const bf16x8 Af = *(const LAS bf16x8*)(BN + (32 * st + cl) * CNS + 16 * ks + 8 * hi), Bf = *(const LAS bf16x8*)(CN + (32 * lt + cl) * CNS + 16 * ks + 8 * hi);
                X = MFMA32(Af, Bf, X); }
#pragma unroll
            for (int q = 0; q < 4; ++q) { const f32x4 as4 = *(const LAS f32x4*)(ACS + r * 64 + 32 * st + 8 * q + 4 * hi), ds4 = *(const LAS f32x4*)(DTL + r * 64 + 32 * st + 8 * q + 4 * hi);
#pragma unroll
                for (int j = 0; j < 4; ++j) { const int s = 32 * st + 8 * q + 4 * hi + j; const float v = X[4 * q + j] * __expf(fminf(al - as4[j], 0.f)) * ds4[j]; X[4 * q + j] = (s <= 32 * lt + cl) ? v : 0.f; } }
            bf16x8 pa[2];
#pragma unroll
            for (int s2 = 0; s2 < 2; ++s2) { u32x4 pw; pw.x = cvtpk_c(X[8 * s2], X[8 * s2 + 1]); pw.y = cvtpk_c(X[8 * s2 + 2], X[8 * s2 + 3]); pw.z = cvtpk_c(X[8 * s2 + 4], X[8 * s2 + 5]); pw.w = cvtpk_c(X[8 * s2 + 6], X[8 * s2 + 7]);
                pa[s2] = __builtin_bit_cast(bf16x8, pw); }
#pragma unroll
            for (int pt = 0; pt < 2; ++pt)
#pragma unroll
                for (int s2 = 0; s2 < 2; ++s2) { const LAS bf16_t* xp = XT + (r * 64 + 32 * pt + cl) * XTS + 32 * st + 16 * s2 + 4 * hi;
                    const u32x2 lo2 = *(const LAS u32x2*)xp, hi2 = *(const LAS u32x2*)(xp + 8); const u32x4 bw = (u32x4){lo2.x, lo2.y, hi2.x, hi2.y};
                    acc[pt] = MFMA32(pa[s2], __builtin_bit_cast(bf16x8, bw), acc[pt]); }
        }
        const float Dh = pq->in[I_DSKIP][hd]; float yv[2][16];
#pragma unroll
        for (int pt = 0; pt < 2; ++pt)
#pragma unroll
            for (int q = 0; q < 4; ++q) { const int pp = 32 * pt + cl, l0 = 32 * lt + 8 * q + 4 * hi;
                const u32x2 xw = *(const LAS u32x2*)(XT + (r * 64 + pp) * XTS + l0);
                yv[pt][4 * q] = acc[pt][4 * q] + Dh * bflo(xw.x); yv[pt][4 * q + 1] = acc[pt][4 * q + 1] + Dh * bfhi(xw.x); yv[pt][4 * q + 2] = acc[pt][4 * q + 2] + Dh * bflo(xw.y); yv[pt][4 * q + 3] = acc[pt][4 * q + 3] + Dh * bfhi(xw.y); }
        __syncthreads();
        LAS float* YL = (LAS float*)lds;
#pragma unroll
        for (int pt = 0; pt < 2; ++pt)
#pragma unroll
            for (int q = 0; q < 4; ++q)
#pragma unroll
                for (int j = 0; j < 4; ++j) YL[(32 * lt + 8 * q + 4 * hi + j) * YLS + r * 64 + 32 * pt + cl] = yv[pt][4 * q + j];
        __syncthreads();
        { const int l = tid >> 3, cs = (tid & 7) * 32; merge_thread<4, 8>(pq, 64 * c + l, g * 256 + cs, YL + l * YLS + cs); }
    }
}

__device__ __forceinline__ void ssd_seq4(PP pq, LAS unsigned char* lds, int tid, int lane, int wave, int b, int g) {
    const int row0 = SEQ + b * NSL;
    __syncthreads(); ssd_stage(pq, lds, tid, lane, wave, row0, NSL, g, pq->in[I_SCONV] + (size_t)b * 3 * CONVD, 1); __syncthreads();
    LAS bf16_t* CN = (LAS bf16_t*)(lds + SD_CN); LAS bf16_t* BN = (LAS bf16_t*)(lds + SD_BN); LAS bf16_t* XT = (LAS bf16_t*)(lds + SD_XT); LAS float* DTL = (LAS float*)(lds + SD_DTL);
    LAS float* YL = (LAS float*)(lds + 94208);
    const int r = tid >> 7, pp = (tid & 127) >> 1, nh = tid & 1, n0 = nh * 64, hd = 4 * g + r;
    const float A = -__expf(pq->in[I_ALOG][hd]), Dh = pq->in[I_DSKIP][hd];
    const float* sin_ = pq->in[I_SSM] + ((size_t)(b * SH + hd) * SP + pp) * SN + n0; float* sout = pq->out + O_SS + ((size_t)(b * SH + hd) * SP + pp) * SN + n0;
    float st[64];
#pragma unroll
    for (int j4 = 0; j4 < 16; ++j4) { const f32x4 v = *(const f32x4*)(sin_ + 4 * j4); st[4 * j4] = v.x; st[4 * j4 + 1] = v.y; st[4 * j4 + 2] = v.z; st[4 * j4 + 3] = v.w; }
#pragma unroll 1
    for (int t = 0; t < NSL; ++t) {
        const float dtv = DTL[r * 64 + t], dA = __expf(dtv * A), x = bf2f(XT[(r * 64 + pp) * XTS + t]), xdt = x * dtv; float y = 0.f;
#pragma unroll
        for (int j4 = 0; j4 < 16; ++j4) { const u32x2 bw = *(const LAS u32x2*)(BN + t * CNS + n0 + 4 * j4), cw2 = *(const LAS u32x2*)(CN + t * CNS + n0 + 4 * j4);
            st[4 * j4] = st[4 * j4] * dA + xdt * bflo(bw.x); y += bflo(cw2.x) * st[4 * j4];
            st[4 * j4 + 1] = st[4 * j4 + 1] * dA + xdt * bfhi(bw.x); y += bfhi(cw2.x) * st[4 * j4 + 1];
            st[4 * j4 + 2] = st[4 * j4 + 2] * dA + xdt * bflo(bw.y); y += bflo(cw2.y) * st[4 * j4 + 2];
            st[4 * j4 + 3] = st[4 * j4 + 3] * dA + xdt * bfhi(bw.y); y += bfhi(cw2.y) * st[4 * j4 + 3]; }
        y += __shfl_xor(y, 1);
        if (nh == 0) YL[t * YLS + r * 64 + pp] = y + Dh * x;
    }
#pragma unroll
    for (int j4 = 0; j4 < 16; ++j4) *(f32x4*)(sout + 4 * j4) = (f32x4){st[4 * j4], st[4 * j4 + 1], st[4 * j4 + 2], st[4 * j4 + 3]};
    __syncthreads();
    { const int t = tid >> 5, cs = (tid & 31) * 8; merge_thread<1, 32>(pq, row0 + t, g * 256 + cs, YL + t * YLS + cs); }
}
__device__ __forceinline__ void sample_ssd4_units(PP pq, LAS unsigned char* lds, int tid, int lane, int wave) {
    for (int v = blockIdx.x; v < NSB * SG; v += gridDim.x) ssd_seq4(pq, lds, tid, lane, wave, v >> 2, v & 3);
}

template <int EPI>
__device__ __forceinline__ void small_gemm(const bf16_t* __restrict__ A, const bf16_t* __restrict__ Bt, int N, int K, void* Out, int ldo, LAS unsigned char* lds, int tid, int lane, int wave) {
    const int nct = N / 64, nitems = 4 * nct, cl = lane & 31, hi = lane >> 5, kw = K / 8;
    LAS float* RED = (LAS float*)lds;
    for (int it = blockIdx.x; it < nitems; it += gridDim.x) { const int mt = it / nct, nt = it - mt * nct;
        f32x16 acc[2][2];
#pragma unroll
        for (int a = 0; a < 2; ++a)
#pragma unroll
            for (int b = 0; b < 2; ++b)
#pragma unroll
                for (int i = 0; i < 16; ++i) acc[a][b][i] = 0.f;
        const bf16_t* a0 = A + (size_t)(64 * mt + cl) * K + wave * kw + 8 * hi; const bf16_t* b0 = Bt + (size_t)(64 * nt + cl) * K + wave * kw + 8 * hi;
#pragma unroll 4
        for (int ks = 0; ks < kw / 16; ++ks) {
            const bf16x8 A0 = *(const bf16x8*)(a0 + 16 * ks), A1 = *(const bf16x8*)(a0 + (size_t)32 * K + 16 * ks), B0 = *(const bf16x8*)(b0 + 16 * ks), B1 = *(const bf16x8*)(b0 + (size_t)32 * K + 16 * ks);
            acc[0][0] = MFMA32(A0, B0, acc[0][0]); acc[0][1] = MFMA32(A0, B1, acc[0][1]); acc[1][0] = MFMA32(A1, B0, acc[1][0]); acc[1][1] = MFMA32(A1, B1, acc[1][1]); }
        __syncthreads();
#pragma unroll
        for (int a = 0; a < 2; ++a)
#pragma unroll
            for (int b = 0; b < 2; ++b)
#pragma unroll
                for (int i = 0; i < 16; ++i) RED[(wave * 64 + 32 * a + (i & 3) + 8 * (i >> 2) + 4 * hi) * 64 + 32 * b + cl] = acc[a][b][i];
        __syncthreads();
#pragma unroll
        for (int qd = 0; qd < 2; ++qd) { const int e = tid + NTHR * qd, row = e >> 4, c4 = (e & 15) * 4; f32x4 sum = (f32x4){0.f, 0.f, 0.f, 0.f};
#pragma unroll
            for (int w8 = 0; w8 < 8; ++w8) sum += *(const LAS f32x4*)(RED + (w8 * 64 + row) * 64 + c4);
            if (EPI == 0) *(f32x4*)((float*)Out + (size_t)(64 * mt + row) * ldo + 64 * nt + c4) = sum;
            else if (EPI == 2) { u32x2 wv; wv.x = cvtpk_c(sum.x, sum.y); wv.y = cvtpk_c(sum.z, sum.w); *(u32x2*)((bf16_t*)Out + (size_t)(64 * mt + row) * ldo + 64 * nt + c4) = wv; }
            else { const float r0 = fmaxf(sum.x, 0.f), r1 = fmaxf(sum.y, 0.f), r2 = fmaxf(sum.z, 0.f), r3 = fmaxf(sum.w, 0.f); u32x2 wv; wv.x = cvtpk_c(r0 * r0, r1 * r1); wv.y = cvtpk_c(r2 * r2, r3 * r3);
                *(u32x2*)((bf16_t*)Out + (size_t)(64 * mt + row) * ldo + 64 * nt + c4) = wv; } }
    }
    __syncthreads();
}

__device__ __forceinline__ void sample_attn_units(PP pq, LAS unsigned char* lds, int tid) {
    for (int u = blockIdx.x; u < 128; u += gridDim.x) sample_attn(pq, lds, tid, u >> 3, u & 7);
}
__device__ __forceinline__ void sample_ssd_units(PP pq, LAS unsigned char* lds, int tid) {
    for (int v = blockIdx.x; v < 256; v += gridDim.x) { const int b = v >> 4, hd = v & 15;
        ssd_seq(pq, lds, tid, SEQ + b * 16, NSL, 16, hd, pq->in[I_SSM] + (size_t)b * SH * SP * SN, pq->out + O_SS + (size_t)b * SH * SP * SN, pq->in[I_SCONV] + (size_t)b * 3 * CONVD); }
}

__device__ __forceinline__ void phase6(PP pq, int lane, int gw, int ngw) {
    const bf16_t* Qb = WSP(bf16_t, WS_Q); const bf16_t* Zb = WSP(bf16_t, WS_Z); bf16_t* H = WSP(bf16_t, WS_H); const float* sng = pq->in[I_SNG];
    for (int row = gw; row < R; row += ngw) {
        const bool smp = row >= SEQ; const int srow = row - SEQ; const size_t ro = (size_t)row * DM + 16 * lane;
        const bf16_t* gap = smp ? WSP(bf16_t, WS_GAS) + (size_t)srow * DM + 16 * lane : (const bf16_t*)(pq->out + O_YP) + ro;
        const bf16_t* gbp = smp ? WSP(bf16_t, WS_GBS) + (size_t)srow * DM + 16 * lane : (const bf16_t*)(pq->out + O_YP) + (size_t)SEQ * DM + ro;
        float ya[16], ys[16], ga[16], gb[16];
        unpack16(H + ro, ya); unpack16(WSP(bf16_t, WS_YS) + ro, ys); unpack16(gap, ga); unpack16(gbp, gb);
        float ss = 0.f;
#pragma unroll
        for (int e = 0; e < 16; ++e) ss += ys[e] * ys[e];
        ss += __shfl_xor(ss, 1); ss += __shfl_xor(ss, 2); ss += __shfl_xor(ss, 4); ss += __shfl_xor(ss, 8);
        const float rstd = 1.f / sqrtf(ss * (1.f / 256.f) + EPS);
        float m[16];
#pragma unroll
        for (int e4 = 0; e4 < 4; ++e4) { const f32x4 gg = *(const f32x4*)(sng + 16 * lane + 4 * e4);
#pragma unroll
            for (int j = 0; j < 4; ++j) { const int e = 4 * e4 + j; m[e] = sigmoidf_(ga[e]) * ya[e] + sigmoidf_(gb[e]) * (ys[e] * rstd * gg[j]); } }
        u32x4 w0, w1; w0.x = pk2(m[0], m[1]); w0.y = pk2(m[2], m[3]); w0.z = pk2(m[4], m[5]); w0.w = pk2(m[6], m[7]);
        w1.x = pk2(m[8], m[9]); w1.y = pk2(m[10], m[11]); w1.z = pk2(m[12], m[13]); w1.w = pk2(m[14], m[15]);
        *(u32x4*)(H + ro) = w0; *(u32x4*)(H + ro + 8) = w1;
    }
}

__device__ __forceinline__ void phase8(PP pq, int lane, int gw, int ngw) {
    const float* mod = WSP(float, WS_MOD); const bf16_t* MF = WSP(bf16_t, WS_MF); bf16_t* H = WSP(bf16_t, WS_H); const float* gqm = pq->in[I_GQM];
    for (int row0 = gw; row0 < R; row0 += 2 * ngw) {
        const int r1 = row0 + ngw; const bool has1 = r1 < R; int rr[2] = {row0, has1 ? r1 : row0};
        f32x4 v[2][4], xv[2][4], x1[2][4]; float rs[2], rs2[2]; const float* mr[2];
#pragma unroll
        for (int a = 0; a < 2; ++a) { const u32x2* mr4 = (const u32x2*)(MF + (size_t)rr[a] * DM) + lane; const f32x4* xr = (const f32x4*)xrow_ptr(pq, rr[a]) + lane; mr[a] = mod + (size_t)modrow(rr[a]) * 6144;
#pragma unroll
            for (int j = 0; j < 4; ++j) { { const u32x2 mw = __builtin_nontemporal_load(mr4 + 64 * j);     v[a][j] = (f32x4){bflo(mw.x), bfhi(mw.x), bflo(mw.y), bfhi(mw.y)}; } xv[a][j] = xr[64 * j]; } }
#pragma unroll
        for (int a = 0; a < 2; ++a) rs[a] = 1.f / sqrtf(wave_sum(sumsq4(v[a])) * (1.f / DM) + EPS);
#pragma unroll
        for (int a = 0; a < 2; ++a) { f32x4* yr = (f32x4*)yrow_ptr(pq, rr[a]) + lane;
#pragma unroll
            for (int j = 0; j < 4; ++j) { const int c = 4 * lane + 256 * j; const f32x4 gt = *(const f32x4*)(mr[a] + 2048 + c), gg = *(const f32x4*)(gqm + c);
                x1[a][j] = xv[a][j] + gt * (v[a][j] * rs[a] * gg); if (a == 0 || has1) yr[64 * j] = x1[a][j]; } }
#pragma unroll
        for (int a = 0; a < 2; ++a) rs2[a] = 1.f / sqrtf(wave_sum(sumsq4(x1[a])) * (1.f / DM) + EPS);
        modnorm_store(x1[0], rs2[0], pq->in[I_GPF], mr[0] + 4096, mr[0] + 3072, H + (size_t)rr[0] * DM, lane);
        if (has1) modnorm_store(x1[1], rs2[1], pq->in[I_GPF], mr[1] + 4096, mr[1] + 3072, H + (size_t)rr[1] * DM, lane);
    }
}
__device__ __forceinline__ void phase11(PP pq, int lane, int gw, int ngw) {
    const float* mod = WSP(float, WS_MOD); const bf16_t* MF = WSP(bf16_t, WS_MF); const float* gqf = pq->in[I_GQF];
    for (int row0 = gw; row0 < R; row0 += 2 * ngw) {
        const int r1 = row0 + ngw; const bool has1 = r1 < R; int rr[2] = {row0, has1 ? r1 : row0};
        f32x4 v[2][4], yv[2][4]; float rs[2];
#pragma unroll
        for (int a = 0; a < 2; ++a) { const u32x2* fr4 = (const u32x2*)(MF + (size_t)rr[a] * DM) + lane; const f32x4* yr = (const f32x4*)yrow_ptr(pq, rr[a]) + lane;
#pragma unroll
            for (int j = 0; j < 4; ++j) { { const u32x2 fw = __builtin_nontemporal_load(fr4 + 64 * j); v[a][j] = (f32x4){bflo(fw.x), bfhi(fw.x), bflo(fw.y), bfhi(fw.y)}; } yv[a][j] = __builtin_nontemporal_load(yr + 64 * j); } }
#pragma unroll
        for (int a = 0; a < 2; ++a) rs[a] = 1.f / sqrtf(wave_sum(sumsq4(v[a])) * (1.f / DM) + EPS);
#pragma unroll
        for (int a = 0; a < 2; ++a) { if (a == 1 && !has1) break; f32x4* yr = (f32x4*)yrow_ptr(pq, rr[a]) + lane; const float* mr = mod + (size_t)modrow(rr[a]) * 6144;
#pragma unroll
            for (int j = 0; j < 4; ++j) { const int c = 4 * lane + 256 * j; const f32x4 gt = *(const f32x4*)(mr + 5120 + c), gg = *(const f32x4*)(gqf + c);
                yr[64 * j] = yv[a][j] + gt * (v[a][j] * rs[a] * gg); } }
    }
}

constexpr int NPHASE = 14;
__global__ void __launch_bounds__(NTHR, 2) fox_ssd_fwd(Params p) {
    extern __shared__ __attribute__((aligned(16))) unsigned char lds[];
    cg::grid_group grid = cg::this_grid();
    LAS unsigned char* ldsL = (LAS unsigned char*)lds;
    constexpr int BST_OFF = LDS_BYTES - 64;
    { PP q0 = kparams(); if (threadIdx.x < 2) ((volatile LAS unsigned*)(ldsL + BST_OFF))[threadIdx.x] = 0u; __syncthreads();
      if (q0->ph_hi - q0->ph_lo > 1) (void)xcd_barrier_post((unsigned*)(q0->ws + WS_BAR), (volatile LAS unsigned*)(ldsL + BST_OFF));
      if (q0->ph_lo < 0) grid.sync(); }
#define PV PP pq = kparams(); const int tid = launder_tid(), lane = tid & 63, wave = __builtin_amdgcn_readfirstlane(tid >> 6), gw = blockIdx.x * NWV + wave, ngw = gridDim.x * NWV; (void)lane; (void)gw; (void)ngw; (void)pq;
#ifndef ONLYP
#define ONLYP -1
#endif
#define IN(k) (in_phase(k) && (ONLYP < 0 || ONLYP == (k)))
#define GSYNC() do { XcdBarrier bar_; bar_.bar = (unsigned*)(kparams()->ws + WS_BAR); bar_.x = xb_xcc_id(); bar_.st = (volatile LAS unsigned*)(ldsL + BST_OFF); xcd_barrier(bar_); } while (0)
#define SEAM(k) do { if (IN(k) && IN((k) + 1)) GSYNC(); } while (0)
#ifndef REP_MASK
#define REP_MASK 0
#endif
#define PHASE(k, ...) do { if (IN(k)) { for (int rep_ = 0; rep_ <= ((REP_MASK >> (k)) & 1); ++rep_) { if (rep_) GSYNC(); PV __VA_ARGS__ } } SEAM(k); } while (0)
    PHASE(0, phase0(pq, ldsL, tid, lane, wave););
    PHASE(1, phase1(pq, lane, gw, ngw););
    PHASE(2, pg8::Gemm g{WSP(pg8::bf16_t, WS_H), WSP(pg8::bf16_t, WS_WTIN), R, NIN, DM}; pg8::StaticOrder S; S.init(R, NIN, gridDim.x, blockIdx.x); pg8::EpiIn E{0};
        pg8::gemm_phase<pg8::EpiIn, pg8::StaticOrder, true, true>(ldsL, g, S, E);
        { const int G = gridDim.x, nun = (R / 256) * (NIN / 256), rounds = (nun + G - 1) / G, r0 = nun - (rounds - 1) * G;
          __syncthreads();
          if (r0 >= G) late_transposes(pq, ldsL, tid, (int)blockIdx.x, G);
          else if ((int)blockIdx.x >= r0) late_transposes(pq, ldsL, tid, (int)blockIdx.x - r0, G - r0); });
    PHASE(3, phase3(pq, ldsL, tid, lane, wave););
    PHASE(4, phase4(pq, (char*)lds); __syncthreads(); sample_attn_units(pq, ldsL, tid););
    if (IN(5) && IN(6)) { for (int rep_ = 0; rep_ <= ((REP_MASK >> 5) & 1); ++rep_) { if (rep_) GSYNC(); { PV ssd_passA(pq, ldsL, tid, lane, wave); } GSYNC(); { PV ssd_scan(pq, tid); } } }
    else { if (IN(5)) { PV ssd_passA(pq, ldsL, tid, lane, wave); } if (IN(6)) { PV ssd_scan(pq, tid); } }
    SEAM(6);
    PHASE(7, ssd_passC(pq, ldsL, tid, lane, wave); sample_ssd4_units(pq, ldsL, tid, lane, wave););
    PHASE(9, small_gemm<2>(WSP(bf16_t, WS_H) + (size_t)SEQ * DM, WSP(bf16_t, WS_WTOUT), DM, DM, WSP(bf16_t, WS_MF) + (size_t)SEQ * DM, DM, ldsL, tid, lane, wave);
        pg8::Gemm g{WSP(pg8::bf16_t, WS_H), WSP(pg8::bf16_t, WS_WTOUT), SEQ, DM, DM}; pg8::StaticOrder S; S.init(SEQ, DM, gridDim.x, blockIdx.x); pg8::EpiBf E{WSP(pg8::bf16_t, WS_MF), DM};
        pg8::gemm_phase<pg8::EpiBf, pg8::StaticOrder, true, true>(ldsL, g, S, E););
    PHASE(10, phase8(pq, lane, gw, ngw););
    PHASE(11, small_gemm<1>(WSP(bf16_t, WS_H) + (size_t)SEQ * DM, WSP(bf16_t, WS_WTUP), DFF, DM, WSP(bf16_t, WS_HID) + (size_t)SEQ * DFF, DFF, ldsL, tid, lane, wave);
        pg8::Gemm g{WSP(pg8::bf16_t, WS_H), WSP(pg8::bf16_t, WS_WTUP), SEQ, DFF, DM}; pg8::StaticOrder S; S.init(SEQ, DFF, gridDim.x, blockIdx.x); pg8::EpiRelu2 E{WSP(pg8::bf16_t, WS_HID), DFF};
        pg8::gemm_phase<pg8::EpiRelu2, pg8::StaticOrder, true, true>(ldsL, g, S, E););
    PHASE(12, small_gemm<2>(WSP(bf16_t, WS_HID) + (size_t)SEQ * DFF, WSP(bf16_t, WS_WTDN), DM, DFF, WSP(bf16_t, WS_MF) + (size_t)SEQ * DM, DM, ldsL, tid, lane, wave);
        pg8::Gemm g{WSP(pg8::bf16_t, WS_HID), WSP(pg8::bf16_t, WS_WTDN), SEQ, DM, DFF}; pg8::StaticOrder S; S.init(SEQ, DM, gridDim.x, blockIdx.x); pg8::EpiBf E{WSP(pg8::bf16_t, WS_MF), DM};
        pg8::gemm_phase<pg8::EpiBf, pg8::StaticOrder, true, true>(ldsL, g, S, E););
    if (IN(13)) { PV phase11(pq, lane, gw, ngw); }
#undef IN
#undef SEAM
}

#ifndef MK_PER_PHASE
#define MK_PER_PHASE 0
#endif
extern "C" void kernel_launch(void* const* d_in, const int* in_sizes, int n_in, void* d_out, int out_size, void* d_ws, size_t ws_size, hipStream_t stream) {
    static int grid = 0;
    if (grid == 0) {
        if (n_in != 26 || out_size != (int)O_END || ws_size < WS_END) { fprintf(stderr, "kernel_launch: unexpected shapes n_in %d out %d ws %zu (need %zu)\n", n_in, out_size, ws_size, (size_t)WS_END); grid = -1; return; }
        int dev = 0, cus = 0, per_cu = 0;
        (void)hipGetDevice(&dev);
        if (hipDeviceGetAttribute(&cus, hipDeviceAttributeMultiprocessorCount, dev) != hipSuccess || cus <= 0) cus = 256;
        if (hipFuncSetAttribute((const void*)fox_ssd_fwd, hipFuncAttributeMaxDynamicSharedMemorySize, LDS_BYTES) != hipSuccess) fprintf(stderr, "kernel_launch: hipFuncSetAttribute failed\n");
        if (hipOccupancyMaxActiveBlocksPerMultiprocessor(&per_cu, (const void*)fox_ssd_fwd, NTHR, LDS_BYTES) != hipSuccess || per_cu < 1) { fprintf(stderr, "kernel_launch: occupancy query says %d\n", per_cu); per_cu = 1; }
        (void)hipGetLastError();
        grid = cus * per_cu;
    }
    if (grid < 0) return;
    if (hipMemsetAsync((char*)d_ws + WS_BAR, 0, 16384, stream) != hipSuccess) { fprintf(stderr, "kernel_launch: memset of barrier words failed\n"); return; }
    Params p{};
    for (int i = 0; i < 26; ++i) p.in[i] = (const float*)d_in[i];
    p.out = (float*)d_out; p.ws = (unsigned char*)d_ws;
#if MK_PER_PHASE
    for (int k = 0; k < NPHASE; ++k) { p.ph_lo = k; p.ph_hi = k + 1; hipLaunchKernelGGL(fox_ssd_fwd, dim3(grid), dim3(NTHR), LDS_BYTES, stream, p); }
#else
    p.ph_lo = 0; p.ph_hi = NPHASE;
    void* args[] = {&p};
    hipError_t e = hipLaunchCooperativeKernel((const void*)fox_ssd_fwd, dim3(grid), dim3(NTHR), args, LDS_BYTES, stream);
    if (e != hipSuccess) fprintf(stderr, "kernel_launch: cooperative launch failed: %s (grid %d)\n", hipGetErrorString(e), grid);
#endif
}
```
